# Optimizing an MI355X kernel written in HIP

```python
import math
import jax, jax.numpy as jnp
from jax import lax
import numpy as np

D_MODEL = 1024
BATCH = 8
SEQ = 2048
DEPTH = 1
DEC_BATCH = 128
DEC_SEQ = 4
PAST_LEN = 16384
PAGE_SIZE = 128

D_CONV = D_MODEL // 2
D_SSM = D_MODEL - D_CONV
D_MIX = D_CONV + D_SSM
CONV_WIDTH = 31
CONV_GROUP = 64
N_CONV_GROUPS = D_CONV // CONV_GROUP
SSM_GROUP = 16
N_SSM_GROUPS = D_SSM // SSM_GROUP
SSM_STATE = 64
N_MEM = 256
N_MEM_HEADS = 4
MEM_HEAD_DIM = D_MODEL // N_MEM_HEADS
D_FF = ((8 * D_MODEL + 3 * 256 - 1) // (3 * 256)) * 256
N_NORMS = 6
RMS_EPS = 1e-6
LN_EPS = 1e-5

kernel_name = "hymba_conformer_s5_memxattn_decode_step"


def rms_norm(x, g):
    xf = x.astype(jnp.float32)
    y = xf * lax.rsqrt(jnp.mean(xf * xf, axis=-1, keepdims=True) + RMS_EPS)
    return (y * g.astype(jnp.float32)).astype(x.dtype)


def layer_norm(x, g, b):
    xf = x.astype(jnp.float32)
    xc = xf - jnp.mean(xf, axis=-1, keepdims=True)
    var = jnp.mean(xc * xc, axis=-1, keepdims=True)
    y = xc * lax.rsqrt(var + LN_EPS) * g.astype(jnp.float32) + b.astype(jnp.float32)
    return y.astype(x.dtype)


def causal_depthwise_conv(v_ext, w_dw, b_dw):
    c = v_ext.shape[-1]
    out = lax.conv_general_dilated(
        v_ext, w_dw.astype(v_ext.dtype)[:, None, :], window_strides=(1,), padding="VALID",
        dimension_numbers=("NWC", "WIO", "NWC"), feature_group_count=c)
    return out + b_dw.astype(v_ext.dtype)


def _ssm_combine(left, right):
    a_l, b_l = left
    a_r, b_r = right
    return a_r * a_l, a_r * b_l + b_r


def s5_layer(u, h0, lam_re, lam_im, log_dt, b_re, b_im, c_re, c_im, d_skip, w_glu):
    f32 = jnp.float32
    bsz, t, _ = u.shape
    lam = lax.complex(lam_re.astype(f32), lam_im.astype(f32))
    dt = jnp.exp(log_dt.astype(f32))[:, None]
    a_bar = jnp.exp(lam * dt)
    b_mat = lax.complex(b_re.astype(f32), b_im.astype(f32))
    b_bar = ((a_bar - 1.0) / lam)[:, :, None] * b_mat
    c_mat = lax.complex(c_re.astype(f32), c_im.astype(f32))
    uf = u.astype(f32).reshape(bsz, t, N_SSM_GROUPS, SSM_GROUP)
    bu = jnp.einsum("btgp,gnp->btgn", uf.astype(jnp.complex64), b_bar)
    bu = bu.at[:, 0].add(a_bar * h0)
    a_seq = jnp.broadcast_to(a_bar, bu.shape)
    _, hs = lax.associative_scan(_ssm_combine, (a_seq, bu), axis=1)
    y = jnp.einsum("btgn,gpn->btgp", hs, c_mat).real
    y = y + d_skip.astype(f32).reshape(N_SSM_GROUPS, SSM_GROUP) * uf
    y = jax.nn.gelu(y.reshape(bsz, t, D_SSM))
    out = y * jax.nn.sigmoid(y @ w_glu.astype(f32))
    return out, hs[:, -1]


def token_mixer(h, conv_buf, ssm_h0, w_in, w_dw, b_dw, ln_g, ln_b, lam_re, lam_im, log_dt,
                b_re, b_im, c_re, c_im, d_skip, w_glu, w_out):
    z = h @ w_in
    a = z[..., :D_CONV]
    g = z[..., D_CONV:2 * D_CONV]
    u = z[..., 2 * D_CONV:]
    v = a * jax.nn.sigmoid(g)
    v_ext = jnp.concatenate([conv_buf.astype(v.dtype), v], axis=1)
    conv_new = v_ext[:, v_ext.shape[1] - (CONV_WIDTH - 1):]
    c = jax.nn.silu(layer_norm(causal_depthwise_conv(v_ext, w_dw, b_dw), ln_g, ln_b))
    s, h_last = s5_layer(u, ssm_h0, lam_re, lam_im, log_dt, b_re, b_im, c_re, c_im, d_skip, w_glu)
    mix = jnp.concatenate([c, s.astype(c.dtype)], axis=-1)
    return mix @ w_out, conv_new, h_last


def mem_kv(mem, g_mem, w_k, w_v):
    bsz = mem.shape[0]
    m = rms_norm(mem, g_mem)
    k = (m @ w_k).reshape(bsz, N_MEM, N_MEM_HEADS, MEM_HEAD_DIM)
    v = (m @ w_v).reshape(bsz, N_MEM, N_MEM_HEADS, MEM_HEAD_DIM)
    return k, v


def mem_attend(h, mem_k, mem_v, w_q, w_o):
    bsz, t, _ = h.shape
    q = (h @ w_q).reshape(bsz, t, N_MEM_HEADS, MEM_HEAD_DIM).astype(jnp.float32)
    s = jnp.einsum("bthd,bmhd->bhtm", q, mem_k.astype(jnp.float32)) * (MEM_HEAD_DIM ** -0.5)
    p = jax.nn.softmax(s, axis=-1)
    o = jnp.einsum("bhtm,bmhd->bthd", p, mem_v.astype(jnp.float32))
    return o.astype(h.dtype).reshape(bsz, t, D_MODEL) @ w_o


def swiglu(h, w_gate, w_up, w_down):
    return (jax.nn.silu(h @ w_gate) * (h @ w_up)) @ w_down


def block(x, mem_k, mem_v, conv_buf, ssm_h0, norm_g, mix_w, attn_w, ffn_w):
    h = rms_norm(x, norm_g[0])
    m, conv_new, h_last = token_mixer(h, conv_buf, ssm_h0, *mix_w)
    x = x + rms_norm(m, norm_g[1])
    h = rms_norm(x, norm_g[2])
    x = x + rms_norm(mem_attend(h, mem_k, mem_v, *attn_w), norm_g[3])
    h = rms_norm(x, norm_g[4])
    x = x + rms_norm(swiglu(h, *ffn_w), norm_g[5])
    return x, conv_new, h_last


def setup_inputs(seed: int = 0) -> dict:
    key = jax.random.key(seed)
    ks = jax.random.split(key, 40)
    f32 = jnp.float32
    nrm = lambda k, shape, s: s * jax.random.normal(k, shape, f32)
    L = DEPTH
    lam_im_base = math.pi * jnp.arange(SSM_STATE, dtype=f32)
    return {
        "x_prompt": nrm(ks[0], (BATCH, SEQ, D_MODEL), 1.0),
        "x_sample": nrm(ks[1], (DEC_BATCH, DEC_SEQ, D_MODEL), 1.0),
        "mem_prompt": nrm(ks[2], (BATCH, N_MEM, D_MODEL), 1.0),
        "cache_mem_k": nrm(ks[3], (L, DEC_BATCH, N_MEM, N_MEM_HEADS, MEM_HEAD_DIM), 1.0),
        "cache_mem_v": nrm(ks[4], (L, DEC_BATCH, N_MEM, N_MEM_HEADS, MEM_HEAD_DIM), 1.0),
        "state_conv": nrm(ks[5], (L, DEC_BATCH, CONV_WIDTH - 1, D_CONV), 0.5),
        "state_ssm_re": nrm(ks[6], (L, DEC_BATCH, N_SSM_GROUPS, SSM_STATE), 0.1),
        "state_ssm_im": nrm(ks[7], (L, DEC_BATCH, N_SSM_GROUPS, SSM_STATE), 0.1),
        "norm_g": 1.0 + nrm(ks[8], (L, N_NORMS, D_MODEL), 0.05),
        "mem_norm_g": 1.0 + nrm(ks[9], (L, D_MODEL), 0.05),
        "w_in": nrm(ks[10], (L, D_MODEL, 2 * D_CONV + D_SSM), D_MODEL ** -0.5),
        "w_dw": nrm(ks[11], (L, CONV_WIDTH, D_CONV), CONV_WIDTH ** -0.5),
        "b_dw": nrm(ks[12], (L, D_CONV), 0.01),
        "ln_g": 1.0 + nrm(ks[13], (L, D_CONV), 0.05),
        "ln_b": nrm(ks[14], (L, D_CONV), 0.01),
        "lam_re": -0.5 + nrm(ks[15], (L, N_SSM_GROUPS, SSM_STATE), 0.01),
        "lam_im": lam_im_base + nrm(ks[16], (L, N_SSM_GROUPS, SSM_STATE), 0.01),
        "log_dt": jax.random.uniform(ks[17], (L, N_SSM_GROUPS), f32, math.log(1e-3), math.log(1e-1)),
        "b_re": nrm(ks[18], (L, N_SSM_GROUPS, SSM_STATE, SSM_GROUP), (2 * SSM_GROUP) ** -0.5),
        "b_im": nrm(ks[19], (L, N_SSM_GROUPS, SSM_STATE, SSM_GROUP), (2 * SSM_GROUP) ** -0.5),
        "c_re": nrm(ks[20], (L, N_SSM_GROUPS, SSM_GROUP, SSM_STATE), (2 * SSM_STATE) ** -0.5),
        "c_im": nrm(ks[21], (L, N_SSM_GROUPS, SSM_GROUP, SSM_STATE), (2 * SSM_STATE) ** -0.5),
        "d_skip": nrm(ks[22], (L, D_SSM), 1.0),
        "w_glu": nrm(ks[23], (L, D_SSM, D_SSM), D_SSM ** -0.5),
        "w_out": nrm(ks[24], (L, D_MIX, D_MODEL), D_MIX ** -0.5),
        "w_q": nrm(ks[25], (L, D_MODEL, D_MODEL), D_MODEL ** -0.5),
        "w_k": nrm(ks[26], (L, D_MODEL, D_MODEL), D_MODEL ** -0.5),
        "w_v": nrm(ks[27], (L, D_MODEL, D_MODEL), D_MODEL ** -0.5),
        "w_o": nrm(ks[28], (L, D_MODEL, D_MODEL), D_MODEL ** -0.5),
        "w_gate": nrm(ks[29], (L, D_MODEL, D_FF), D_MODEL ** -0.5),
        "w_up": nrm(ks[30], (L, D_MODEL, D_FF), D_MODEL ** -0.5),
        "w_down": nrm(ks[31], (L, D_FF, D_MODEL), D_FF ** -0.5),
    }


def reference(x_prompt, x_sample, mem_prompt, cache_mem_k, cache_mem_v, state_conv,
              state_ssm_re, state_ssm_im, norm_g, mem_norm_g, w_in, w_dw, b_dw, ln_g, ln_b,
              lam_re, lam_im, log_dt, b_re, b_im, c_re, c_im, d_skip, w_glu, w_out,
              w_q, w_k, w_v, w_o, w_gate, w_up, w_down):
    f32 = jnp.float32
    yp, ys = x_prompt, x_sample
    kps, vps, cps, hps_re, hps_im, css, hss_re, hss_im = [], [], [], [], [], [], [], []
    for l in range(DEPTH):
        mix_w = (w_in[l], w_dw[l], b_dw[l], ln_g[l], ln_b[l], lam_re[l], lam_im[l], log_dt[l],
                 b_re[l], b_im[l], c_re[l], c_im[l], d_skip[l], w_glu[l], w_out[l])
        attn_w = (w_q[l], w_o[l])
        ffn_w = (w_gate[l], w_up[l], w_down[l])
        kp, vp = mem_kv(mem_prompt, mem_norm_g[l], w_k[l], w_v[l])
        conv0 = jnp.zeros((yp.shape[0], CONV_WIDTH - 1, D_CONV), yp.dtype)
        h0 = jnp.zeros((yp.shape[0], N_SSM_GROUPS, SSM_STATE), jnp.complex64)
        yp, cp, hp = block(yp, kp, vp, conv0, h0, norm_g[l], mix_w, attn_w, ffn_w)
        hs0 = lax.complex(state_ssm_re[l].astype(f32), state_ssm_im[l].astype(f32))
        ys, cs, hs = block(ys, cache_mem_k[l], cache_mem_v[l], state_conv[l], hs0,
                           norm_g[l], mix_w, attn_w, ffn_w)
        kps.append(kp)
        vps.append(vp)
        cps.append(cp)
        hps_re.append(hp.real)
        hps_im.append(hp.imag)
        css.append(cs)
        hss_re.append(hs.real)
        hss_im.append(hs.imag)
    return (yp, ys, jnp.stack(kps), jnp.stack(vps), jnp.stack(cps), jnp.stack(hps_re),
            jnp.stack(hps_im), jnp.stack(css), jnp.stack(hss_re), jnp.stack(hss_im))
```

```cpp
#include <hip/hip_runtime.h>
#include <hip/hip_cooperative_groups.h>
#include <cstdio>
#include <cstdint>
namespace cg = cooperative_groups;

#ifndef MEGA
#define MEGA 1
#endif

#define LAS __attribute__((address_space(3)))
typedef unsigned short bf16_t;
typedef short bf16x8 __attribute__((ext_vector_type(8)));
typedef float f32x4 __attribute__((ext_vector_type(4)));
typedef float f32x16 __attribute__((ext_vector_type(16)));
typedef unsigned u32x2 __attribute__((ext_vector_type(2)));

constexpr int NP = 16384, NS = 512, NTOK = NP + NS, DM = 1024, DC = 512, DFF = 2816;
constexpr int HTB = 128 * 64 * 2;
constexpr int LDS_BYTES = 8 * HTB + 8192;
constexpr int NTHR = 512;

struct Params {
  const float *x_prompt, *x_sample, *mem_prompt, *cache_k, *cache_v, *state_conv, *st_re, *st_im, *norm_g, *mem_norm_g,
      *w_in, *w_dw, *b_dw, *ln_g, *ln_b, *lam_re, *lam_im, *log_dt, *b_re, *b_im, *c_re, *c_im, *d_skip, *w_glu, *w_out,
      *w_q, *w_k, *w_v, *w_o, *w_gate, *w_up, *w_down;
  float *y, *memk, *memv, *convp, *sre_p, *sim_p, *convs, *sre_s, *sim_s;
  bf16_t *xb, *memb, *WinT, *WkvT, *WgluT, *WoutT, *WqT, *WoT, *WguT, *WdT, *TY, *ST, *vbuf, *A2, *yact, *mix, *gob, *x1b,
      *qb, *kb, *vT, *Pscr, *ob, *x2b, *actb;
  float *rstd0, *rstdm, *abar, *a16, *Bbre, *Bbim, *usamp, *Sst, *ssq, *rstd1, *rstd2;
  float *apw, *Ktab;
  unsigned* bar;
};

__device__ __forceinline__ bf16_t f2bf(float f) { unsigned r; asm("v_cvt_pk_bf16_f32 %0, %1, %1" : "=v"(r) : "v"(f)); return (bf16_t)(r & 0xffffu); }
__device__ __forceinline__ float bf2f(bf16_t h) { return __uint_as_float(((unsigned)h) << 16); }
__device__ __forceinline__ unsigned pack2(float a, float b) { unsigned r; asm("v_cvt_pk_bf16_f32 %0, %1, %2" : "=v"(r) : "v"(a), "v"(b)); return r; }
__device__ __forceinline__ void st_bf4(bf16_t* p, f32x4 v) { u32x2 o; o.x = pack2(v[0], v[1]); o.y = pack2(v[2], v[3]); *(u32x2*)p = o; }
typedef unsigned u32x4_ __attribute__((ext_vector_type(4)));
__device__ __forceinline__ void st_bf8(bf16_t* p, f32x4 a, f32x4 b) { u32x4_ o = {pack2(a[0], a[1]), pack2(a[2], a[3]), pack2(b[0], b[1]), pack2(b[2], b[3])}; *(u32x4_*)p = o; }
__device__ __forceinline__ f32x4 ld_bf4(const bf16_t* p) { u32x2 o = *(const u32x2*)p; f32x4 v; v[0] = __uint_as_float(o.x << 16); v[1] = __uint_as_float(o.x & 0xffff0000u); v[2] = __uint_as_float(o.y << 16); v[3] = __uint_as_float(o.y & 0xffff0000u); return v; }
__device__ __forceinline__ f32x4 ld_bf4_nt(const bf16_t* p) { u32x2 o = __builtin_nontemporal_load((const u32x2*)p); f32x4 v; v[0] = __uint_as_float(o.x << 16); v[1] = __uint_as_float(o.x & 0xffff0000u); v[2] = __uint_as_float(o.y << 16); v[3] = __uint_as_float(o.y & 0xffff0000u); return v; }
__device__ __forceinline__ float sigmoidf_(float x) { return __builtin_amdgcn_rcpf(1.f + __expf(-x)); }
__device__ __forceinline__ float siluf_(float x) { return x * sigmoidf_(x); }
__device__ __forceinline__ float gelu_tanh(float y) { float z = 0.7978845608028654f * (y + 0.044715f * y * y * y); float t = 1.f - 2.f * __builtin_amdgcn_rcpf(1.f + __expf(2.f * z)); return 0.5f * y * (1.f + t); }
__device__ __forceinline__ int tid_opq() { int t = threadIdx.x; asm volatile("" : "+v"(t)); return t; }
__device__ __forceinline__ float sq4(f32x4 v) { return v[0] * v[0] + v[1] * v[1] + v[2] * v[2] + v[3] * v[3]; }
__device__ __forceinline__ float wave_sum(float v) { for (int o = 32; o > 0; o >>= 1) v += __shfl_xor(v, o); return v; }
__device__ __forceinline__ float wave_max(float v) { for (int o = 32; o > 0; o >>= 1) v = fmaxf(v, __shfl_xor(v, o)); return v; }

__device__ __forceinline__ int lds_byte(int r, int c) { const int st = (r >> 4) * 2 + (c >> 5), rr = r & 15, cc = c & 31, ob = rr * 64 + cc * 2; return st * 1024 + (ob ^ (((ob >> 9) & 1) << 5)); }
__device__ __forceinline__ void stage_rc(int b, int& R, int& C) { const int st = b / 1024, sb = b % 1024, swz = sb ^ (((sb >> 9) & 1) << 5); R = (st >> 1) * 16 + swz / 64; C = (st & 1) * 32 + (swz % 64) / 2; }

#define G_SA(b, h) (((b) * 2 + (h)) * HTB)
#define G_SB(b, h) ((4 + (b) * 2 + (h)) * HTB)
#define G_STAGE(bufoff, gbase, voff) do { _Pragma("unroll") for (int _i = 0; _i < 2; ++_i) \
    __builtin_amdgcn_global_load_lds((const unsigned*)((const char*)(gbase) + (voff)[_i]), (LAS unsigned*)(lds + (bufoff) + ldsw + _i * 8192), 16, 0, 0); } while (0)
#define G_LDA(dst, b, h) do { _Pragma("unroll") for (int m = 0; m < 4; ++m) _Pragma("unroll") for (int k = 0; k < 2; ++k) dst[m][k] = *(const LAS bf16x8*)(lds + G_SA(b, h) + aoff + m * 2048 + k * 1024); } while (0)
#define G_LDB(dst, b, h) do { _Pragma("unroll") for (int n = 0; n < 2; ++n) _Pragma("unroll") for (int k = 0; k < 2; ++k) dst[n][k] = *(const LAS bf16x8*)(lds + G_SB(b, h) + boff + n * 2048 + k * 1024); } while (0)
#define G_MMA(ai, bj, At, Bt) do { __builtin_amdgcn_s_setprio(1); _Pragma("unroll") for (int m = 0; m < 4; ++m) _Pragma("unroll") for (int n = 0; n < 2; ++n) _Pragma("unroll") for (int k = 0; k < 2; ++k) \
    acc[ai][bj][m][n] = __builtin_amdgcn_mfma_f32_16x16x32_bf16(Bt[n][k], At[m][k], acc[ai][bj][m][n], 0, 0, 0); __builtin_amdgcn_s_setprio(0); } while (0)
#define G_WAIT_V(n) asm volatile("s_waitcnt vmcnt(" #n ")" ::: "memory")
#define G_WAIT_L(n) asm volatile("s_waitcnt lgkmcnt(" #n ")" ::: "memory")
#define G_BAR __builtin_amdgcn_s_barrier()
#define G_SCHED __builtin_amdgcn_sched_barrier(0)

template <bool PRE = false>
__device__ __forceinline__ void gemm_core(LAS unsigned char* lds, const bf16_t* A, int lda, const bf16_t* Bt, int ldb, int K, f32x4 (&acc)[2][2][4][2]) {
  int tid = threadIdx.x; asm volatile("" : "+v"(tid));
  const int wid = __builtin_amdgcn_readfirstlane(tid >> 6), lane = tid & 63, wr = wid >> 2, wc = wid & 3, fr = lane & 15, fq = lane >> 4;
  unsigned voffA[2], voffB[2];
#pragma unroll
  for (int i = 0; i < 2; ++i) { int R, C; stage_rc(tid * 16 + i * 8192, R, C); voffA[i] = (unsigned)(R * lda + C) * 2u; voffB[i] = (unsigned)(R * ldb + C) * 2u; }
  const size_t hA = (size_t)128 * lda * 2, hB = (size_t)128 * ldb * 2;
  const unsigned ldsw = (unsigned)wid * 1024u;
  const int aoff = lds_byte(wr * 64 + fr, fq * 8), boff = lds_byte(wc * 32 + fr, fq * 8);
  const char* cA = (const char*)A; const char* cB = (const char*)Bt;
#pragma unroll
  for (int a = 0; a < 2; ++a)
#pragma unroll
    for (int b = 0; b < 2; ++b)
#pragma unroll
      for (int m = 0; m < 4; ++m)
#pragma unroll
        for (int n = 0; n < 2; ++n) acc[a][b][m][n] = (f32x4){0.f, 0.f, 0.f, 0.f};
  bf16x8 At[4][2], B0[2][2], B1[2][2];
  const int nt = K / 64;
  if (!PRE) {
    G_STAGE(G_SB(0, 0), cB, voffB); G_STAGE(G_SA(0, 0), cA, voffA); G_STAGE(G_SB(0, 1), cB + hB, voffB); G_STAGE(G_SA(0, 1), cA + hA, voffA);
    if (wr == 1) G_BAR;
    G_WAIT_V(4); G_BAR;
  } else {
    if (wr == 1) G_BAR;
    G_WAIT_V(0); G_BAR;
  }
  G_STAGE(G_SB(1, 0), cB + 128, voffB); G_STAGE(G_SA(1, 0), cA + 128, voffA); G_STAGE(G_SB(1, 1), cB + hB + 128, voffB);
  G_WAIT_V(6); G_BAR;
  for (int t = 0; t < nt - 2; t += 2) {
    const char* a1 = cA + (size_t)(t + 1) * 128; const char* a2 = cA + (size_t)(t + 2) * 128; const char* b2 = cB + (size_t)(t + 2) * 128;
    const char* a3 = a2 + 128; const char* b3 = b2 + 128;
    G_LDB(B0, 0, 0); G_SCHED; G_LDA(At, 0, 0); G_STAGE(G_SA(1, 1), a1 + hA, voffA);
    G_WAIT_L(8); G_BAR; G_WAIT_L(0); G_MMA(0, 0, At, B0); G_BAR; G_SCHED;
    G_LDB(B1, 0, 1); G_STAGE(G_SB(0, 0), b2, voffB);
    G_BAR; G_WAIT_L(0); G_MMA(0, 1, At, B1); G_BAR;
    G_LDA(At, 0, 1); G_STAGE(G_SA(0, 0), a2, voffA);
    G_BAR; G_WAIT_L(0); G_MMA(1, 0, At, B0); G_BAR; G_SCHED;
    G_STAGE(G_SB(0, 1), b2 + hB, voffB);
    G_WAIT_V(6); G_BAR; G_MMA(1, 1, At, B1); G_BAR;
    G_LDB(B0, 1, 0); G_SCHED; G_LDA(At, 1, 0); G_STAGE(G_SA(0, 1), a2 + hA, voffA);
    G_WAIT_L(8); G_BAR; G_WAIT_L(0); G_MMA(0, 0, At, B0); G_BAR; G_SCHED;
    G_LDB(B1, 1, 1); G_STAGE(G_SB(1, 0), b3, voffB);
    G_BAR; G_WAIT_L(0); G_MMA(0, 1, At, B1); G_BAR;
    G_LDA(At, 1, 1); G_STAGE(G_SA(1, 0), a3, voffA);
    G_BAR; G_WAIT_L(0); G_MMA(1, 0, At, B0); G_BAR; G_SCHED;
    G_STAGE(G_SB(1, 1), b3 + hB, voffB);
    G_WAIT_V(6); G_BAR; G_MMA(1, 1, At, B1); G_BAR;
  }
  { const char* al = cA + (size_t)(nt - 1) * 128;
    G_LDB(B0, 0, 0); G_LDA(At, 0, 0); G_STAGE(G_SA(1, 1), al + hA, voffA);
    G_BAR; G_WAIT_L(0); G_MMA(0, 0, At, B0); G_BAR;
    G_LDB(B1, 0, 1); G_BAR; G_WAIT_L(0); G_MMA(0, 1, At, B1); G_BAR;
    G_LDA(At, 0, 1); G_WAIT_V(4); G_BAR; G_WAIT_L(0); G_MMA(1, 0, At, B0); G_MMA(1, 1, At, B1); G_BAR; }
  { G_LDB(B0, 1, 0); G_LDA(At, 1, 0); G_WAIT_V(2); G_BAR; G_WAIT_L(0); G_MMA(0, 0, At, B0); G_BAR;
    G_LDB(B1, 1, 1); G_WAIT_V(0); G_BAR; G_WAIT_L(0); G_MMA(0, 1, At, B1); G_BAR;
    G_LDA(At, 1, 1); G_BAR; G_WAIT_L(0); G_MMA(1, 0, At, B0); G_MMA(1, 1, At, B1); G_BAR; }
  if (wr == 0) G_BAR;
}

__device__ __forceinline__ void gemm_prestage(LAS unsigned char* lds, const bf16_t* A, int lda, const bf16_t* Bt, int ldb) {
  int tid = threadIdx.x; asm volatile("" : "+v"(tid));
  const int wid = __builtin_amdgcn_readfirstlane(tid >> 6);
  unsigned voffA[2], voffB[2];
#pragma unroll
  for (int i = 0; i < 2; ++i) { int R, C; stage_rc(tid * 16 + i * 8192, R, C); voffA[i] = (unsigned)(R * lda + C) * 2u; voffB[i] = (unsigned)(R * ldb + C) * 2u; }
  const size_t hA = (size_t)128 * lda * 2, hB = (size_t)128 * ldb * 2;
  const unsigned ldsw = (unsigned)wid * 1024u;
  const char* cA = (const char*)A; const char* cB = (const char*)Bt;
  G_STAGE(G_SB(0, 0), cB, voffB); G_STAGE(G_SA(0, 0), cA, voffA); G_STAGE(G_SB(0, 1), cB + hB, voffB); G_STAGE(G_SA(0, 1), cA + hA, voffA);
}

__device__ __forceinline__ int xcd_tile_id(int r) { const int per = gridDim.x >> 3; return (r * 8 + (blockIdx.x & 7)) * per + (blockIdx.x >> 3); }
__device__ __forceinline__ void tile_pmn(int id, int nM, int nN, int GM, int& pm, int& pn) {
  const int per = GM * nN, grp = id / per, within = id - grp * per, gsz = (nM - grp * GM) < GM ? (nM - grp * GM) : GM;
  pn = within / gsz; pm = grp * GM + within - pn * gsz;
}

template <bool SSQ, int MODE, class Epi>
__device__ __forceinline__ void big_tile(LAS unsigned char* lds, const bf16_t* A, int lda, const bf16_t* Bt, int ldb, int K, int rowbase, int colbase, float* ssqp, Epi epi) {
  __syncthreads();
  f32x4 acc[2][2][4][2];
  gemm_core(lds, A, lda, Bt, ldb, K, acc);
  int tid = threadIdx.x; asm volatile("" : "+v"(tid));
  const int wid = tid >> 6, lane = tid & 63, wr = wid >> 2, wc = wid & 3, fr = lane & 15, fq = lane >> 4;
#pragma unroll
  for (int ai = 0; ai < 2; ++ai)
#pragma unroll
    for (int m = 0; m < 4; ++m) {
      const int row = rowbase + ai * 128 + wr * 64 + m * 16 + fr; float ss = 0.f;
#pragma unroll
      for (int n = 0; n < 2; ++n) if constexpr (MODE != 2) ss += epi(row, colbase + wc * 32 + (MODE == 1 ? fq * 8 + n * 4 : n * 16 + fq * 4), acc[ai][0][m][n], acc[ai][1][m][n]);
      if constexpr (MODE == 2) ss += epi(row, colbase + wc * 32 + fq * 8, acc[ai][0][m][0], acc[ai][0][m][1], acc[ai][1][m][0], acc[ai][1][m][1]);
      if (SSQ) { ss += __shfl_xor(ss, 16); ss += __shfl_xor(ss, 32); if (fq == 0) ssqp[(size_t)wc * NTOK + row] = ss; }
      __builtin_amdgcn_sched_barrier(0);
    }
}

template <bool SSQ, class Epi>
__device__ __forceinline__ void small_tile(const bf16_t* A, int lda, const bf16_t* B0, int ldb, int K, int rowbase, int colbase, float* ssqp, Epi epi) {
  const int lane = threadIdx.x & 63, r = lane & 31, h = lane >> 5;
  const bf16_t* pa = A + (size_t)r * lda + h * 8; const bf16_t* pb0 = B0 + (size_t)r * ldb + h * 8; const bf16_t* pb1 = pb0 + (size_t)128 * ldb;
  f32x16 c0, c1;
#pragma unroll
  for (int i = 0; i < 16; ++i) { c0[i] = 0.f; c1[i] = 0.f; }
#pragma unroll 4
  for (int k = 0; k < K; k += 16) {
    bf16x8 a = *(const bf16x8*)(pa + k), b0 = *(const bf16x8*)(pb0 + k), b1 = *(const bf16x8*)(pb1 + k);
    c0 = __builtin_amdgcn_mfma_f32_32x32x16_bf16(b0, a, c0, 0, 0, 0);
    c1 = __builtin_amdgcn_mfma_f32_32x32x16_bf16(b1, a, c1, 0, 0, 0);
  }
  float ss = 0.f;
#pragma unroll
  for (int q4 = 0; q4 < 4; ++q4) {
    f32x4 v0 = {c0[4 * q4], c0[4 * q4 + 1], c0[4 * q4 + 2], c0[4 * q4 + 3]}, v1 = {c1[4 * q4], c1[4 * q4 + 1], c1[4 * q4 + 2], c1[4 * q4 + 3]};
    ss += epi(rowbase + r, colbase + 8 * q4 + 4 * h, v0, v1);
  }
  if (SSQ) { ss += __shfl_xor(ss, 32); if (h == 0) ssqp[rowbase + r] = ss; }
}

__device__ __forceinline__ void p0_s5tables(LAS float* L, const Params& p, int g) {
  const int tid = threadIdx.x;
  LAS float* apr = L;
  LAS float* api = L + 1088;
  LAS float* bbr = L + 2176;
  LAS float* bbi = L + 3200;
  LAS float* cre = L + 4224;
  LAS float* cim = L + 5248;
  __syncthreads();
  if (tid < 64) {
    const int n = tid;
    float brow[16], birow[16];
#pragma unroll
    for (int q4 = 0; q4 < 4; ++q4) { const f32x4 a = *(const f32x4*)(p.b_re + (g * 64 + n) * 16 + q4 * 4), b = *(const f32x4*)(p.b_im + (g * 64 + n) * 16 + q4 * 4);
#pragma unroll
      for (int j = 0; j < 4; ++j) { brow[q4 * 4 + j] = a[j]; birow[q4 * 4 + j] = b[j]; } }
    const double lr = (double)p.lam_re[g * 64 + n], li = (double)p.lam_im[g * 64 + n], dt = exp((double)p.log_dt[g]);
    const double er = exp(lr * dt), ar = er * cos(li * dt), ai = er * sin(li * dt);
    const double den = lr * lr + li * li, cr = ((ar - 1.0) * lr + ai * li) / den, ci = (ai * lr - (ar - 1.0) * li) / den;
    double pr = 1.0, pi = 0.0;
    for (int j = 0; j <= 16; ++j) { apr[j * 64 + n] = (float)pr; api[j * 64 + n] = (float)pi; const double nr = pr * ar - pi * ai, ni = pr * ai + pi * ar; pr = nr; pi = ni; }
    p.abar[(g * 64 + n) * 2] = (float)ar; p.abar[(g * 64 + n) * 2 + 1] = (float)ai;
    p.a16[(g * 64 + n) * 2] = apr[16 * 64 + n]; p.a16[(g * 64 + n) * 2 + 1] = api[16 * 64 + n];
#pragma unroll
    for (int q = 0; q < 16; ++q) {
      const double br = (double)brow[q], bi = (double)birow[q];
      const float xr = (float)(cr * br - ci * bi), xi = (float)(cr * bi + ci * br);
      bbr[n * 16 + q] = xr; bbi[n * 16 + q] = xi; p.Bbre[(g * 64 + n) * 16 + q] = xr; p.Bbim[(g * 64 + n) * 16 + q] = xi;
    }
  }
  for (int i = tid; i < 1024; i += NTHR) { cre[i] = p.c_re[g * 1024 + i]; cim[i] = p.c_im[g * 1024 + i]; }
  __syncthreads();
  for (int i = tid; i < 1088; i += NTHR) { p.apw[(size_t)g * 2176 + i] = apr[i]; p.apw[(size_t)g * 2176 + 1088 + i] = api[i]; }
  if (tid < 256) {
    const int pp = tid >> 4, q = tid & 15; float kacc[16];
#pragma unroll
    for (int j = 0; j < 16; ++j) kacc[j] = 0.f;
    for (int n = 0; n < 64; ++n) {
      const float ar = apr[64 + n], ai = api[64 + n], cr_ = cre[pp * 64 + n], ci_ = cim[pp * 64 + n], br = bbr[n * 16 + q], bi = bbi[n * 16 + q];
      float er = cr_ * br - ci_ * bi, ei = cr_ * bi + ci_ * br;
#pragma unroll
      for (int j = 0; j < 16; ++j) { kacc[j] += er; const float nr = er * ar - ei * ai, ni = er * ai + ei * ar; er = nr; ei = ni; }
    }
    const float dsk = (pp == q) ? p.d_skip[g * 16 + pp] : 0.f;
#pragma unroll
    for (int j = 0; j < 16; ++j) p.Ktab[(size_t)g * 4096 + (j << 8) + tid] = kacc[j] + (j == 0 ? dsk : 0.f);
  }
}

typedef unsigned u32x4 __attribute__((ext_vector_type(4)));
__device__ __forceinline__ void p1_s5mats(LAS float* L, const Params& p, int g) {
  const int tid = threadIdx.x;
  LAS float* apr = L;
  LAS float* api = L + 1088;
  LAS float* bbr = L + 2176;
  LAS float* bbi = L + 3200;
  LAS float* cre = L + 4224;
  LAS float* cim = L + 5248;
  LAS float* Kt = L + 6272;
  __syncthreads();
  for (int i = tid; i < 1088; i += NTHR) { apr[i] = p.apw[(size_t)g * 2176 + i]; api[i] = p.apw[(size_t)g * 2176 + 1088 + i]; }
  for (int i = tid; i < 1024; i += NTHR) { bbr[i] = p.Bbre[g * 1024 + i]; bbi[i] = p.Bbim[g * 1024 + i]; cre[i] = p.c_re[g * 1024 + i]; cim[i] = p.c_im[g * 1024 + i]; }
  for (int i = tid; i < 4096; i += NTHR) Kt[i] = p.Ktab[(size_t)g * 4096 + i];
  __syncthreads();
  bf16_t* TY = p.TY + (size_t)g * 256 * 384;
  for (int ch = tid; ch < 256 * 48; ch += NTHR) {
    const int row = ch / 48, k0 = (ch - row * 48) * 8, t = row >> 4, pp = row & 15; float v[8];
    if (k0 < 256) { const int s_ = k0 >> 4, q0 = k0 & 15;
#pragma unroll
      for (int j = 0; j < 8; ++j) v[j] = (s_ <= t) ? Kt[((t - s_) << 8) + (pp << 4) + q0 + j] : 0.f; }
    else if (k0 < 320) {
#pragma unroll
      for (int j = 0; j < 8; ++j) { const int n = k0 - 256 + j; v[j] = cre[pp * 64 + n] * apr[(t + 1) * 64 + n] - cim[pp * 64 + n] * api[(t + 1) * 64 + n]; } }
    else {
#pragma unroll
      for (int j = 0; j < 8; ++j) { const int n = k0 - 320 + j; v[j] = -(cre[pp * 64 + n] * api[(t + 1) * 64 + n] + cim[pp * 64 + n] * apr[(t + 1) * 64 + n]); } }
    u32x4 o = {pack2(v[0], v[1]), pack2(v[2], v[3]), pack2(v[4], v[5]), pack2(v[6], v[7])};
    *(u32x4*)(TY + (size_t)row * 384 + k0) = o;
  }
  bf16_t* ST = p.ST + (size_t)g * 256 * 256;
  for (int ch = tid; ch < 256 * 32; ch += NTHR) {
    const int row = ch >> 5, k0 = (ch & 31) * 8, s_ = k0 >> 4, q0 = k0 & 15; float v[8];
#pragma unroll
    for (int j = 0; j < 8; ++j) v[j] = 0.f;
    if (row < 128) { const int n = row & 63; const float pr = apr[(15 - s_) * 64 + n], pi = api[(15 - s_) * 64 + n];
#pragma unroll
      for (int j = 0; j < 8; ++j) { const float br = bbr[n * 16 + q0 + j], bi = bbi[n * 16 + q0 + j]; v[j] = (row < 64) ? (pr * br - pi * bi) : (pr * bi + pi * br); } }
    u32x4 o = {pack2(v[0], v[1]), pack2(v[2], v[3]), pack2(v[4], v[5]), pack2(v[6], v[7])};
    *(u32x4*)(ST + (size_t)row * 256 + k0) = o;
  }
}

__device__ __forceinline__ void p0_transpose4(LAS float* L, const float* src, int N, int Kd, const float* scale, bf16_t* dst, int tk, int tn4, int mode) {
  const int tid = threadIdx.x;
  f32x4 v[4][2]; float sc[2];
#pragma unroll
  for (int i = 0; i < 2; ++i) { const int kk = (tid >> 4) + i * 32; sc[i] = scale ? scale[tk * 64 + kk] : 1.f;
#pragma unroll
    for (int u = 0; u < 4; ++u) v[u][i] = *(const f32x4*)(src + (size_t)(tk * 64 + kk) * N + (tn4 * 4 + u) * 64 + (tid & 15) * 4); }
  __syncthreads();
#pragma unroll
  for (int u = 0; u < 4; ++u)
#pragma unroll
    for (int i = 0; i < 2; ++i) { const int kk = (tid >> 4) + i * 32, nn = (tid & 15) * 4; LAS float* T = L + u * 4160 + kk * 65 + nn;
      T[0] = v[u][i][0] * sc[i]; T[1] = v[u][i][1] * sc[i]; T[2] = v[u][i][2] * sc[i]; T[3] = v[u][i][3] * sc[i]; }
  __syncthreads();
  const int nl = tid >> 3, k0 = (tid & 7) * 8;
#pragma unroll
  for (int u = 0; u < 4; ++u) {
    const int n = (tn4 * 4 + u) * 64 + nl; int drow;
    if (mode == 0) drow = n;
    else if (mode == 1) drow = (n < 512) ? ((n >> 7) * 256 + (n & 127)) : (n < 1024 ? (((n - 512) >> 7) * 256 + 128 + (n & 127)) : n);
    else if (mode == 2) drow = (n >> 7) * 256 + (n & 127);
    else drow = (n >> 7) * 256 + 128 + (n & 127);
    drow = (drow & ~31) + (((drow >> 2) & 1) << 4) + (((drow >> 3) & 3) << 2) + (drow & 3);
    LAS float* T = L + u * 4160;
    u32x4 ov = {pack2(T[(k0 + 0) * 65 + nl], T[(k0 + 1) * 65 + nl]), pack2(T[(k0 + 2) * 65 + nl], T[(k0 + 3) * 65 + nl]),
                pack2(T[(k0 + 4) * 65 + nl], T[(k0 + 5) * 65 + nl]), pack2(T[(k0 + 6) * 65 + nl], T[(k0 + 7) * 65 + nl])};
    *(u32x4*)(dst + (size_t)drow * Kd + tk * 64 + k0) = ov;
  }
}

__device__ __forceinline__ void p0_rowcvt4(const float* src, bf16_t* dst, float* rstd) {
  const int lane = threadIdx.x & 63; f32x4 v[4][4];
#pragma unroll
  for (int r = 0; r < 4; ++r)
#pragma unroll
    for (int i = 0; i < 4; ++i) v[r][i] = *(const f32x4*)(src + (size_t)r * 1024 + i * 256 + lane * 4);
#pragma unroll
  for (int r = 0; r < 4; ++r) { float ss = 0.f;
#pragma unroll
    for (int i = 0; i < 4; ++i) { ss += sq4(v[r][i]); st_bf4(dst + (size_t)r * 1024 + i * 256 + lane * 4, v[r][i]); }
    ss = wave_sum(ss); if (lane == 0) rstd[r] = rsqrtf(ss * (1.f / 1024.f) + 1e-6f); }
}

__device__ __forceinline__ void transpose_item(LAS float* L, const Params& p, int j) {
  const float* src; int N, Kd, mode; const float* sc; bf16_t* dst;
  if (j < 96) { src = p.w_in; N = 1536; Kd = 1024; sc = p.norm_g; dst = p.WinT; mode = 1; }
  else if ((j -= 96) < 64) { src = p.w_k; N = 1024; Kd = 1024; sc = p.mem_norm_g; dst = p.WkvT; mode = 0; }
  else if ((j -= 64) < 64) { src = p.w_v; N = 1024; Kd = 1024; sc = p.mem_norm_g; dst = p.WkvT + (size_t)1024 * 1024; mode = 0; }
  else if ((j -= 64) < 16) { src = p.w_glu; N = 512; Kd = 512; sc = nullptr; dst = p.WgluT; mode = 0; }
  else if ((j -= 16) < 64) { src = p.w_out; N = 1024; Kd = 1024; sc = nullptr; dst = p.WoutT; mode = 0; }
  else if ((j -= 64) < 64) { src = p.w_q; N = 1024; Kd = 1024; sc = p.norm_g + 2 * 1024; dst = p.WqT; mode = 0; }
  else if ((j -= 64) < 64) { src = p.w_o; N = 1024; Kd = 1024; sc = nullptr; dst = p.WoT; mode = 0; }
  else if ((j -= 64) < 176) { src = p.w_gate; N = 2816; Kd = 1024; sc = p.norm_g + 4 * 1024; dst = p.WguT; mode = 2; }
  else if ((j -= 176) < 176) { src = p.w_up; N = 2816; Kd = 1024; sc = p.norm_g + 4 * 1024; dst = p.WguT; mode = 3; }
  else { j -= 176; src = p.w_down; N = 1024; Kd = 2816; sc = nullptr; dst = p.WdT; mode = 0; }
  const int nN4 = N / 256, tk = j / nN4, tn4 = j - tk * nN4;
  p0_transpose4(L, src, N, Kd, sc, dst, tk, tn4, mode);
}

__device__ __forceinline__ void phase0(LAS unsigned char* lds, const Params& p) {
  LAS float* L = (LAS float*)lds;
  const int wid = threadIdx.x >> 6;
  constexpr int T_S5 = 32, T_TR = 240, T_ROW = NTOK / 32 + 2048 / 32;
  if (blockIdx.x < T_S5) { p0_s5tables(L, p, blockIdx.x); asm volatile("s_waitcnt vmcnt(0)" ::: "memory"); p1_s5mats(L, p, blockIdx.x); return; }
  for (int it = blockIdx.x - T_S5; it < T_TR + T_ROW; it += gridDim.x - T_S5) {
    int j = it;
    if (j < T_TR) { transpose_item(L, p, j); continue; }
    j -= T_TR;
    if (j < NTOK / 32) { const int row = j * 32 + wid * 4; const float* src = row < NP ? p.x_prompt + (size_t)row * 1024 : p.x_sample + (size_t)(row - NP) * 1024;
      p0_rowcvt4(src, p.xb + (size_t)row * 1024, p.rstd0 + row); }
    else { const int row = (j - NTOK / 32) * 32 + wid * 4; p0_rowcvt4(p.mem_prompt + (size_t)row * 1024, p.memb + (size_t)row * 1024, p.rstdm + row); }
  }
}

__device__ __forceinline__ void phase1(LAS unsigned char* lds, const Params& p) {
  for (int r = 0; r * (int)gridDim.x < 66 * 6 + 64 + 32; ++r) {
    const int it = xcd_tile_id(r);
    if (it >= 66 * 6 + 64 + 32) continue;
    if (it >= 460) {
      int pm, pn; tile_pmn(it - 460, 4, 8, 4, pm, pn);
      auto epi = [=](int row, int c0, f32x4 v0, f32x4 v1) -> float {
#pragma unroll
        for (int hf = 0; hf < 2; ++hf) {
          const int c = c0 + hf * 128; f32x4 v = hf ? v1 : v0; const f32x4 rs = *(const f32x4*)(p.rstdm + c);
          const int rt = (row & ~31) + 8 * ((row >> 2) & 3) + 4 * ((row >> 4) & 1) + (row & 3);
          st_bf4(p.vT + ((size_t)((c >> 8) * 4 + (rt >> 8)) * 256 + (rt & 255)) * 256 + (c & 255), v * rs);
        }
        return 0.f; };
      big_tile<false, 0>(lds, p.WkvT + (size_t)(1024 + pm * 256) * 1024, 1024, p.memb + (size_t)pn * 256 * 1024, 1024, 1024, pm * 256, pn * 256, nullptr, epi);
      continue;
    }
    if (it < 396) {
      int pm, pn; tile_pmn(it, 66, 6, 4, pm, pn);
      auto epi = [=](int row, int c0, f32x4 a0, f32x4 a1, f32x4 b0, f32x4 b1) -> float {
        const float rs = p.rstd0[row];
        if (pn < 4) {
          const int c = pn * 128 + (c0 & 127); f32x4 o0, o1;
#pragma unroll
          for (int j = 0; j < 4; ++j) { o0[j] = (a0[j] * rs) * sigmoidf_(b0[j] * rs); o1[j] = (a1[j] * rs) * sigmoidf_(b1[j] * rs); }
          st_bf8(p.vbuf + (size_t)row * 512 + c, o0, o1);
          if (row < NP) { const int t = row & 2047; if (t >= 2018) { float* d = p.convp + ((size_t)(row >> 11) * 30 + (t - 2018)) * 512 + c; *(f32x4*)d = o0; *(f32x4*)(d + 4) = o1; } }
          else { const int sr = row - NP; float* d = p.convs + ((size_t)(sr >> 2) * 30 + 26 + (sr & 3)) * 512 + c; *(f32x4*)d = o0; *(f32x4*)(d + 4) = o1; }
        } else {
#pragma unroll
          for (int hf = 0; hf < 2; ++hf) {
            const int cc = (c0 - 1024) + hf * 128; f32x4 v0 = hf ? b0 : a0, v1 = hf ? b1 : a1; v0 *= rs; v1 *= rs;
            if (row < NP) { const int g = cc >> 4, pp = cc & 15, b = row >> 11, t = row & 2047;
              st_bf8(p.A2 + ((size_t)g * 1024 + b * 128 + (t >> 4)) * 384 + (t & 15) * 16 + pp, v0, v1); }
            else { float* d = p.usamp + (size_t)(row - NP) * 512 + cc; *(f32x4*)d = v0; *(f32x4*)(d + 4) = v1; }
          }
        }
        return 0.f; };
      big_tile<false, 2>(lds, p.xb + (size_t)pm * 256 * 1024, 1024, p.WinT + (size_t)pn * 256 * 1024, 1024, 1024, pm * 256, pn * 256, nullptr, epi);
    } else {
      int pm, pn; tile_pmn(it - 396, 8, 8, 4, pm, pn);
      auto epi = [=](int row, int c0, f32x4 a0, f32x4 a1, f32x4 b0, f32x4 b1) -> float {
        const float rs = p.rstdm[row]; const int b = row >> 8, mm = row & 255;
#pragma unroll
        for (int hf = 0; hf < 2; ++hf) {
          const int c = c0 + hf * 128; f32x4 v0 = hf ? b0 : a0, v1 = hf ? b1 : a1; v0 *= rs; v1 *= rs;
          if (c < 1024) { float* d = p.memk + (size_t)row * 1024 + c; *(f32x4*)d = v0; *(f32x4*)(d + 4) = v1; st_bf8(p.kb + ((size_t)(b * 4 + (c >> 8)) * 256 + mm) * 256 + (c & 255), v0, v1); }
          else { float* d = p.memv + (size_t)row * 1024 + (c - 1024); *(f32x4*)d = v0; *(f32x4*)(d + 4) = v1; }
        }
        return 0.f; };
      big_tile<false, 2>(lds, p.memb + (size_t)pm * 256 * 1024, 1024, p.WkvT + (size_t)pn * 256 * 1024, 1024, 1024, pm * 256, pn * 256, nullptr, epi);
    }
  }
}

template <int TT, bool SAMPLE>
__device__ __forceinline__ void conv_tile(LAS float* L, const Params& p, int idx) {
  const int c = tid_opq(), wid = c >> 6, lane = c & 63;
  constexpr int NV = TT + 30;
  float vals[NV];
  int R0;
  if (!SAMPLE) {
    const int b = idx / (2048 / TT), t0 = (idx % (2048 / TT)) * TT; R0 = b * 2048 + t0;
#pragma unroll
    for (int j = 0; j < NV; ++j) { const int tt = t0 - 30 + j; const float v = bf2f(p.vbuf[(size_t)(b * 2048 + (tt < 0 ? 0 : tt)) * 512 + c]); vals[j] = tt < 0 ? 0.f : v; }
  } else {
    R0 = NP + idx * 4;
#pragma unroll
    for (int j = 0; j < 30; ++j) vals[j] = p.state_conv[((size_t)idx * 30 + j) * 512 + c];
#pragma unroll
    for (int j = 0; j < TT; ++j) vals[30 + j] = bf2f(p.vbuf[(size_t)(R0 + j) * 512 + c]);
#pragma unroll
    for (int i = 0; i < 26; ++i) p.convs[((size_t)idx * 30 + i) * 512 + c] = vals[i + 4];
  }
  float o[TT]; const float bias = p.b_dw[c];
#pragma unroll
  for (int i = 0; i < TT; ++i) o[i] = bias;
  float wk[31];
#pragma unroll
  for (int k = 0; k < 31; ++k) wk[k] = p.w_dw[k * 512 + c];
#pragma unroll
  for (int k = 0; k < 31; ++k) {
#pragma unroll
    for (int i = 0; i < TT; ++i) o[i] += wk[k] * vals[i + k]; }
  __syncthreads();
  if constexpr (TT == 32) {
    float v[64];
#pragma unroll
    for (int i = 0; i < 32; ++i) { v[i] = o[i]; v[32 + i] = o[i] * o[i]; }
#pragma unroll
    for (int st = 0; st < 6; ++st) {
      const int off = 32 >> st, nn = 32 >> st; const bool up = (lane & off) != 0;
#pragma unroll
      for (int i = 0; i < nn; ++i) { const float send = up ? v[i] : v[i + nn], keep = up ? v[i + nn] : v[i]; v[i] = keep + __shfl_xor(send, off); }
    }
    L[wid * 64 + lane] = v[0];
    __syncthreads();
    if (wid == 0) { float t = 0.f;
#pragma unroll
      for (int w = 0; w < 8; ++w) t += L[w * 64 + lane];
      L[512 + lane] = t; }
    __syncthreads();
  } else {
#pragma unroll
    for (int i = 0; i < TT; ++i) { const float s1 = wave_sum(o[i]), s2 = wave_sum(o[i] * o[i]); if (lane == 0) { L[wid * 64 + i] = s1; L[wid * 64 + 32 + i] = s2; } }
    __syncthreads();
    if (wid == 0) { float t = 0.f;
#pragma unroll
      for (int w = 0; w < 8; ++w) t += L[w * 64 + lane];
      L[512 + lane] = t; }
    __syncthreads();
  }
  const float lg = p.ln_g[c], lb = p.ln_b[c];
#pragma unroll
  for (int i = 0; i < TT; ++i) {
    const float mean = L[512 + i] * (1.f / 512.f), var = fmaxf(L[512 + 32 + i] * (1.f / 512.f) - mean * mean, 0.f);
    const float r = rsqrtf(var + 1e-5f);
    p.mix[(size_t)(R0 + i) * 1024 + c] = f2bf(siluf_((o[i] - mean) * r * lg + lb)); }
}

constexpr int CV_IN = 4096, CV_OUT = 69632;
__device__ __forceinline__ void convp_gload(const Params& p, int idx, int tid, u32x4_ (&g)[8]) {
  const int b = idx >> 6, t0 = (idx & 63) * 32;
#pragma unroll
  for (int i = 0; i < 8; ++i) {
    int ch = tid + i * 512; ch = ch < 3968 ? ch : 3967;
    const int j = ch >> 6, k = ch & 63, tt = t0 - 30 + j;
    u32x4_ v = *(const u32x4_*)(p.vbuf + (size_t)(b * 2048 + (tt < 0 ? 0 : tt)) * 512 + k * 8);
    if (tt < 0) v = (u32x4_){0u, 0u, 0u, 0u};
    g[i] = v;
  }
}
__device__ __forceinline__ void convp_stage(LAS unsigned char* lds, int tid, const u32x4_ (&g)[8], float (&vals)[62]) {
#pragma unroll
  for (int i = 0; i < 8; ++i) { const int ch = tid + i * 512; if (ch < 3968) *(LAS u32x4_*)(lds + CV_IN + ch * 16) = g[i]; }
  __syncthreads();
#pragma unroll
  for (int j = 0; j < 62; ++j) vals[j] = bf2f(*(const LAS unsigned short*)(lds + CV_IN + j * 1024 + tid * 2));
}
__device__ __forceinline__ void convp_fma(const float (&vals)[62], const float (&wk)[31], float bias, float (&o)[32]) {
#pragma unroll
  for (int i = 0; i < 32; ++i) o[i] = bias;
#pragma unroll
  for (int k = 0; k < 31; ++k) {
#pragma unroll
    for (int i = 0; i < 32; ++i) o[i] += wk[k] * vals[i + k]; }
}
__device__ __forceinline__ void convp_finish(LAS unsigned char* lds, const Params& p, int idx, int c, const float (&o)[32], float lg, float lb) {
  LAS float* L = (LAS float*)lds;
  const int wid = c >> 6, lane = c & 63, R0 = (idx >> 6) * 2048 + (idx & 63) * 32;
  __syncthreads();
  float v[64];
#pragma unroll
  for (int i = 0; i < 32; ++i) { v[i] = o[i]; v[32 + i] = o[i] * o[i]; }
#pragma unroll
  for (int st = 0; st < 6; ++st) {
    const int off = 32 >> st, nn = 32 >> st; const bool up = (lane & off) != 0;
#pragma unroll
    for (int i = 0; i < nn; ++i) { const float send = up ? v[i] : v[i + nn], keep = up ? v[i + nn] : v[i]; v[i] = keep + __shfl_xor(send, off); }
  }
  L[wid * 64 + lane] = v[0];
  __syncthreads();
  if (wid == 0) { float t = 0.f;
#pragma unroll
    for (int w = 0; w < 8; ++w) t += L[w * 64 + lane];
    L[512 + lane] = t; }
  __syncthreads();
#pragma unroll
  for (int i = 0; i < 32; ++i) {
    const float mean = L[512 + i] * (1.f / 512.f), var = fmaxf(L[512 + 32 + i] * (1.f / 512.f) - mean * mean, 0.f);
    const float r = rsqrtf(var + 1e-5f);
    *(LAS unsigned short*)(lds + CV_OUT + i * 1024 + c * 2) = f2bf(siluf_((o[i] - mean) * r * lg + lb)); }
  __syncthreads();
#pragma unroll
  for (int i = 0; i < 4; ++i) { const int ch = c + i * 512, row = ch >> 6, k = ch & 63;
    *(u32x4_*)(p.mix + (size_t)(R0 + row) * 1024 + k * 8) = *(const LAS u32x4_*)(lds + CV_OUT + ch * 16); }
}

__device__ __forceinline__ void s5_sample_item(LAS float* L, const Params& p, int item) {
  const int g = item & 31, bc = item >> 5, tid = tid_opq(), wid = tid >> 6, lane = tid & 63, n = lane;
  LAS float* cre = L;
  LAS float* cim = L + 1040;
  LAS float* hL = L + 2080 + wid * 520;
  LAS float* uL = L + 2080 + 8 * 520 + wid * 64;
  __syncthreads();
  for (int i = tid; i < 1024; i += NTHR) { const int pp = i >> 6, nn = i & 63; cre[pp * 65 + nn] = p.c_re[g * 1024 + i]; cim[pp * 65 + nn] = p.c_im[g * 1024 + i]; }
  float br[16], bi[16];
#pragma unroll
  for (int q = 0; q < 16; ++q) { br[q] = p.Bbre[(g * 64 + n) * 16 + q]; bi[q] = p.Bbim[(g * 64 + n) * 16 + q]; }
  const float ar = p.abar[(g * 64 + n) * 2], ai = p.abar[(g * 64 + n) * 2 + 1];
  const float dsk = p.d_skip[g * 16 + (lane & 15)];
  __syncthreads();
  for (int ub = 0; ub < 2; ++ub) {
    const int b = bc * 16 + wid * 2 + ub, unit = b * 32 + g;
    const float uval = p.usamp[(size_t)(b * 4 + (lane >> 4)) * 512 + g * 16 + (lane & 15)];
    uL[lane] = uval;
    float hr = p.st_re[(size_t)unit * 64 + n], hi = p.st_im[(size_t)unit * 64 + n];
    __builtin_amdgcn_wave_barrier();
#pragma unroll
    for (int t = 0; t < 4; ++t) {
      float sr = 0.f, si = 0.f;
#pragma unroll
      for (int q = 0; q < 16; ++q) { const float u = uL[t * 16 + q]; sr += br[q] * u; si += bi[q] * u; }
      const float nr = ar * hr - ai * hi + sr, ni = ar * hi + ai * hr + si; hr = nr; hi = ni;
      hL[t * 130 + 2 * n] = hr; hL[t * 130 + 2 * n + 1] = hi;
    }
    p.sre_s[(size_t)unit * 64 + n] = hr; p.sim_s[(size_t)unit * 64 + n] = hi;
    __builtin_amdgcn_wave_barrier();
    const int t = lane >> 4, pp = lane & 15; float y = 0.f;
#pragma unroll 8
    for (int n2 = 0; n2 < 64; ++n2) y += cre[pp * 65 + n2] * hL[t * 130 + 2 * n2] - cim[pp * 65 + n2] * hL[t * 130 + 2 * n2 + 1];
    y += dsk * uval;
    p.yact[(size_t)(NP + b * 4 + t) * 512 + g * 16 + pp] = f2bf(gelu_tanh(y));
    __builtin_amdgcn_wave_barrier();
  }
}

__device__ __forceinline__ void s5_prompt_tile(LAS unsigned char* lds, const Params& p, int it) {
  const int g = it >> 2, pm = it & 3; const int tid = tid_opq();
  {
    auto epi = [=](int row, int c0, f32x4 v0, f32x4 v1) -> float { *(f32x4*)(p.Sst + ((size_t)g * 1024 + row) * 128 + c0) = v0; return 0.f; };
    big_tile<false, 0>(lds, p.A2 + ((size_t)g * 1024 + pm * 256) * 384, 384, p.ST + (size_t)g * 256 * 256, 256, 256, pm * 256, 0, nullptr, epi);
  }
  asm volatile("s_waitcnt vmcnt(0)" ::: "memory");
  __syncthreads();
  {
    LAS float* E = (LAS float*)lds;
    const int q = tid >> 7, bb = (tid >> 6) & 1, b = pm * 2 + bb, n = tid & 63;
    const float ar = p.a16[(g * 64 + n) * 2], ai = p.a16[(g * 64 + n) * 2 + 1];
    const float* S = p.Sst + ((size_t)g * 1024 + b * 128 + q * 32) * 128 + n;
    bf16_t* H = p.A2 + ((size_t)g * 1024 + b * 128 + q * 32) * 384 + 256 + n;
    float sr[32], si[32];
#pragma unroll
    for (int j = 0; j < 32; ++j) { sr[j] = S[(size_t)j * 128]; si[j] = S[(size_t)j * 128 + 64]; }
    float hr = 0.f, hi = 0.f;
#pragma unroll
    for (int j = 0; j < 32; ++j) { const float xr = sr[j], xi = si[j]; sr[j] = hr; si[j] = hi; const float nr = ar * hr - ai * hi + xr, ni = ar * hi + ai * hr + xi; hr = nr; hi = ni; }
    __syncthreads();
    E[(q * 128 + (tid & 127)) * 2] = hr; E[(q * 128 + (tid & 127)) * 2 + 1] = hi;
    float pr = ar, pi = ai;
#pragma unroll
    for (int k = 0; k < 5; ++k) { const float nr = pr * pr - pi * pi, ni = 2.f * pr * pi; pr = nr; pi = ni; }
    __syncthreads();
    float cr = 0.f, ci = 0.f;
    for (int qq = 0; qq < q; ++qq) { const float er = E[(qq * 128 + (tid & 127)) * 2], ei = E[(qq * 128 + (tid & 127)) * 2 + 1];
      const float nr = pr * cr - pi * ci + er, ni = pr * ci + pi * cr + ei; cr = nr; ci = ni; }
    float wr_ = cr, wi_ = ci;
#pragma unroll
    for (int j = 0; j < 32; ++j) {
      H[(size_t)j * 384] = f2bf(sr[j] + wr_); H[(size_t)j * 384 + 64] = f2bf(si[j] + wi_);
      const float nr = ar * wr_ - ai * wi_, ni = ar * wi_ + ai * wr_; wr_ = nr; wi_ = ni;
    }
    if (q == 3) { p.sre_p[(size_t)(b * 32 + g) * 64 + n] = hr + wr_; p.sim_p[(size_t)(b * 32 + g) * 64 + n] = hi + wi_; }
  }
  asm volatile("s_waitcnt vmcnt(0)" ::: "memory");
  __syncthreads();
  auto epi = [=](int row, int c0, f32x4 v0, f32x4 v1) -> float {
#pragma unroll
    for (int hf = 0; hf < 2; ++hf) {
      const int col = c0 + hf * 128, t = col >> 4, pp = col & 15; f32x4 v = hf ? v1 : v0; f32x4 o;
#pragma unroll
      for (int j = 0; j < 4; ++j) o[j] = gelu_tanh(v[j]);
      st_bf4(p.yact + ((size_t)row * 16 + t) * 512 + g * 16 + pp, o);
    }
    return 0.f; };
  big_tile<false, 0>(lds, p.A2 + ((size_t)g * 1024 + pm * 256) * 384, 384, p.TY + (size_t)g * 256 * 384, 384, 384, pm * 256, 0, nullptr, epi);
  __syncthreads();
}

__device__ __forceinline__ void phase2(LAS unsigned char* lds, const Params& p) {
  LAS float* L = (LAS float*)lds;
  volatile LAS int* slot = (volatile LAS int*)(lds + 8 * HTB + 64);
  constexpr int T_CP = 512, T_S5 = 256, T_CS = 128;
  if (blockIdx.x < 128) s5_prompt_tile(lds, p, blockIdx.x);
  const int c = tid_opq();
  float wk[31]; u32x4_ g[8];
#pragma unroll
  for (int k = 0; k < 31; ++k) wk[k] = p.w_dw[k * 512 + c];
  const float bias = p.b_dw[c], lg = p.ln_g[c], lb = p.ln_b[c];
  auto grab = [&]() -> int {
    __syncthreads();
    if (threadIdx.x == 0) *slot = (int)__hip_atomic_fetch_add(p.bar, 1u, __ATOMIC_RELAXED, __HIP_MEMORY_SCOPE_AGENT);
    __syncthreads();
    return *slot; };
  int cur = grab(); bool loaded = false;
  while (cur < T_CP + T_S5 + T_CS) {
    const int nxt = grab();
    if (cur < T_CP) {
      if (!loaded) convp_gload(p, cur, c, g);
      float vals[62], o[32];
      convp_stage(lds, c, g, vals);
      convp_fma(vals, wk, bias, o);
      loaded = nxt < T_CP; if (loaded) convp_gload(p, nxt, c, g);
      convp_finish(lds, p, cur, c, o, lg, lb);
    } else if (cur < T_CP + T_S5) s5_sample_item(L, p, cur - T_CP);
    else conv_tile<4, true>(L, p, cur - T_CP - T_S5);
    cur = nxt;
  }
}

__device__ __forceinline__ void phase3(LAS unsigned char* lds, const Params& p) {}

__device__ __forceinline__ void phase4(LAS unsigned char* lds, const Params& p) {
  {
    const int id0 = xcd_tile_id(0);
    if (id0 >= 132) { for (int j = 240 + (id0 - 132); j < 960; j += (int)gridDim.x - 132) transpose_item((LAS float*)lds, p, j); return; }
  }
  for (int r = 0; r * (int)gridDim.x < 132; ++r) {
    const int it = xcd_tile_id(r);
    if (it >= 132) continue;
    int pm, pn; tile_pmn(it, 66, 2, 16, pm, pn);
    auto epi = [=](int row, int c0, f32x4 a0, f32x4 a1, f32x4 b0, f32x4 b1) -> float {
#pragma unroll
      for (int hf = 0; hf < 2; ++hf) {
        const int col = c0 + hf * 128; const f32x4 v0 = hf ? b0 : a0, v1 = hf ? b1 : a1;
        const f32x4 y0 = ld_bf4(p.yact + (size_t)row * 512 + col), y1 = ld_bf4(p.yact + (size_t)row * 512 + col + 4); f32x4 o0, o1;
#pragma unroll
        for (int j = 0; j < 4; ++j) { o0[j] = y0[j] * sigmoidf_(v0[j]); o1[j] = y1[j] * sigmoidf_(v1[j]); }
        st_bf8(p.mix + (size_t)row * 1024 + 512 + col, o0, o1);
      }
      return 0.f; };
    big_tile<false, 2>(lds, p.yact + (size_t)pm * 256 * 512, 512, p.WgluT + (size_t)pn * 256 * 512, 512, 512, pm * 256, pn * 256, nullptr, epi);
  }
}

template <bool SSQ, class Epi>
__device__ __forceinline__ void small_tile_sk(LAS float* L, const bf16_t* A, int lda, const bf16_t* B0, int ldb, int K, int rowbase, int colbase, float* ssqp, Epi epi) {
  const int tid = threadIdx.x, wid = tid >> 6, lane = tid & 63, fr = lane & 15, fq = lane >> 4;
  const int kc = K >> 3;
  const bf16_t* pa = A + (size_t)fr * lda + fq * 8 + wid * kc;
  const bf16_t* pb = B0 + (size_t)fr * ldb + fq * 8 + wid * kc;
  f32x4 acc[2][4];
#pragma unroll
  for (int rh = 0; rh < 2; ++rh)
#pragma unroll
    for (int cq = 0; cq < 4; ++cq) acc[rh][cq] = (f32x4){0.f, 0.f, 0.f, 0.f};
#pragma unroll 6
  for (int k = 0; k < kc; k += 32) {
    const bf16x8 a0 = *(const bf16x8*)(pa + k), a1 = *(const bf16x8*)(pa + (size_t)16 * lda + k);
    bf16x8 bq[4];
    bq[0] = *(const bf16x8*)(pb + k); bq[1] = *(const bf16x8*)(pb + (size_t)16 * ldb + k);
    bq[2] = *(const bf16x8*)(pb + (size_t)128 * ldb + k); bq[3] = *(const bf16x8*)(pb + (size_t)144 * ldb + k);
#pragma unroll
    for (int cq = 0; cq < 4; ++cq) {
      acc[0][cq] = __builtin_amdgcn_mfma_f32_16x16x32_bf16(bq[cq], a0, acc[0][cq], 0, 0, 0);
      acc[1][cq] = __builtin_amdgcn_mfma_f32_16x16x32_bf16(bq[cq], a1, acc[1][cq], 0, 0, 0);
    }
  }
  __syncthreads();
#pragma unroll
  for (int rh = 0; rh < 2; ++rh)
#pragma unroll
    for (int cq = 0; cq < 4; ++cq)
#pragma unroll
      for (int j = 0; j < 4; ++j) L[(wid * 32 + (rh * 4 + cq) * 4 + j) * 64 + lane] = acc[rh][cq][j];
  __syncthreads();
  if (wid < 4) {
    const int cql = tid & 1, fq2 = (tid >> 1) & 3, frr = (tid >> 3) & 15, rh = tid >> 7, ls = fq2 * 16 + frr;
    f32x4 v0 = {0.f, 0.f, 0.f, 0.f}, v1 = {0.f, 0.f, 0.f, 0.f};
#pragma unroll
    for (int w = 0; w < 8; ++w)
#pragma unroll
      for (int j = 0; j < 4; ++j) { v0[j] += L[(w * 32 + (rh * 4 + cql) * 4 + j) * 64 + ls]; v1[j] += L[(w * 32 + (rh * 4 + cql + 2) * 4 + j) * 64 + ls]; }
    const int row = rowbase + rh * 16 + frr;
    float ss = epi(row, colbase + 8 * fq2 + 4 * cql, v0, v1);
    if (SSQ) { ss += __shfl_xor(ss, 1); ss += __shfl_xor(ss, 2); ss += __shfl_xor(ss, 4); if ((lane & 7) == 0) ssqp[row] = ss; }
  }
}

template <bool SSQ, class Epi, class Epi8>
__device__ __forceinline__ void gemm_n1024(LAS unsigned char* lds, const Params& p, const bf16_t* A, int lda, const bf16_t* Bt, int K, Epi epi, Epi8 epi8) {
  for (int wt = blockIdx.x; wt < 256; wt += gridDim.x) {
    const int rb = wt & 15, cbk = wt >> 4, pn = cbk >> 2, sub = cbk & 3;
    small_tile_sk<SSQ>((LAS float*)lds, A + (size_t)(NP + rb * 32) * lda, lda, Bt + (size_t)(pn * 256 + sub * 32) * K, K, K, NP + rb * 32, pn * 256 + sub * 32, p.ssq + (size_t)(pn * 4 + sub) * NTOK, epi);
  }
  for (int r = 0; r * (int)gridDim.x < 256; ++r) {
    const int it = xcd_tile_id(r);
    if (it >= 256) continue;
    int pm, pn; tile_pmn(it, 64, 4, 8, pm, pn);
    big_tile<SSQ, 2>(lds, A + (size_t)pm * 256 * lda, lda, Bt + (size_t)pn * 256 * K, K, K, pm * 256, pn * 256, p.ssq + (size_t)(pn * 4) * NTOK, epi8);
  }
}


template <int WHICH>
__device__ __forceinline__ void resid_phase(const Params& p) {
  const int tid = tid_opq(), wid = tid >> 6, lane = tid & 63;
  const float* gain = p.norm_g + (WHICH == 1 ? 1 : (WHICH == 2 ? 3 : 5)) * 1024;
  for (int it = blockIdx.x; it < NTOK / 16; it += gridDim.x) {
    const int row0 = it * 16 + wid * 2;
    float s2[2]; f32x4 xo[2][4], mv[2][4], gv[4];
#pragma unroll
    for (int i = 0; i < 4; ++i) gv[i] = *(const f32x4*)(gain + i * 256 + lane * 4);
#pragma unroll
    for (int r = 0; r < 2; ++r) {
      const int row = row0 + r;
      s2[r] = (lane < 16) ? p.ssq[(size_t)lane * NTOK + row] : 0.f;
#pragma unroll
      for (int i = 0; i < 4; ++i) {
        const int c = i * 256 + lane * 4;
        xo[r][i] = ld_bf4_nt((WHICH == 1 ? p.xb : (WHICH == 2 ? p.x1b : p.x2b)) + (size_t)row * 1024 + c);
        mv[r][i] = ld_bf4_nt(p.gob + (size_t)row * 1024 + c);
      }
    }
#pragma unroll
    for (int r = 0; r < 2; ++r) {
      const int row = row0 + r;
      const float rs = rsqrtf(wave_sum(s2[r]) * (1.f / 1024.f) + 1e-6f);
      float ss = 0.f;
#pragma unroll
      for (int i = 0; i < 4; ++i) { xo[r][i] = xo[r][i] + mv[r][i] * rs * gv[i]; ss += sq4(xo[r][i]); }
      if (WHICH == 3) {
#pragma unroll
        for (int i = 0; i < 4; ++i) *(f32x4*)(p.y + (size_t)row * 1024 + i * 256 + lane * 4) = xo[r][i];
      } else {
        bf16_t* dst = (WHICH == 1 ? p.x1b : p.x2b) + (size_t)row * 1024;
#pragma unroll
        for (int i = 0; i < 4; ++i) st_bf4(dst + i * 256 + lane * 4, xo[r][i]);
        ss = wave_sum(ss);
        if (lane == 0) (WHICH == 1 ? p.rstd1 : p.rstd2)[row] = rsqrtf(ss * (1.f / 1024.f) + 1e-6f);
      }
    }
  }
}

__device__ __forceinline__ void attn_prompt_unit(LAS unsigned char* lds, const Params& p, int u) {
  const int b = u >> 5, h = (u >> 3) & 3, qt = u & 7, R0 = b * 2048 + qt * 256;
  LAS float* red = (LAS float*)lds;
  bf16_t* P = p.Pscr + (size_t)blockIdx.x * 65536;
  __syncthreads();
  {
    f32x4 acc[2][2][4][2];
    gemm_core(lds, p.qb + (size_t)R0 * 1024 + h * 256, 1024, p.kb + (size_t)(b * 4 + h) * 65536, 256, 256, acc);
    int tid = threadIdx.x; asm volatile("" : "+v"(tid));
    const int wid = tid >> 6, lane = tid & 63, wr = wid >> 2, wc = wid & 3, fr = lane & 15, fq = lane >> 4;
    float mx[2][4];
#pragma unroll
    for (int ai = 0; ai < 2; ++ai)
#pragma unroll
      for (int m = 0; m < 4; ++m) { float v = -3.0e38f;
#pragma unroll
        for (int bj = 0; bj < 2; ++bj)
#pragma unroll
          for (int n = 0; n < 2; ++n)
#pragma unroll
            for (int j = 0; j < 4; ++j) v = fmaxf(v, acc[ai][bj][m][n][j]);
        v = fmaxf(v, __shfl_xor(v, 16)); v = fmaxf(v, __shfl_xor(v, 32));
        if (fq == 0) red[wc * 256 + ai * 128 + wr * 64 + m * 16 + fr] = v; __builtin_amdgcn_sched_barrier(0); }
    __syncthreads();
#pragma unroll
    for (int ai = 0; ai < 2; ++ai)
#pragma unroll
      for (int m = 0; m < 4; ++m) { const int r = ai * 128 + wr * 64 + m * 16 + fr; mx[ai][m] = fmaxf(fmaxf(red[r], red[256 + r]), fmaxf(red[512 + r], red[768 + r])); }
    __syncthreads();
#pragma unroll
    for (int ai = 0; ai < 2; ++ai)
#pragma unroll
      for (int m = 0; m < 4; ++m) { float s = 0.f;
#pragma unroll
        for (int bj = 0; bj < 2; ++bj)
#pragma unroll
          for (int n = 0; n < 2; ++n)
#pragma unroll
            for (int j = 0; j < 4; ++j) { const float e = __expf((acc[ai][bj][m][n][j] - mx[ai][m]) * 0.0625f); acc[ai][bj][m][n][j] = e; s += e; }
        s += __shfl_xor(s, 16); s += __shfl_xor(s, 32);
        if (fq == 0) red[wc * 256 + ai * 128 + wr * 64 + m * 16 + fr] = s; __builtin_amdgcn_sched_barrier(0); }
    __syncthreads();
#pragma unroll
    for (int ai = 0; ai < 2; ++ai)
#pragma unroll
      for (int m = 0; m < 4; ++m) { const int r = ai * 128 + wr * 64 + m * 16 + fr; const float inv = 1.f / (red[r] + red[256 + r] + red[512 + r] + red[768 + r]);
#pragma unroll
        for (int bj = 0; bj < 2; ++bj)
#pragma unroll
          for (int n = 0; n < 2; ++n) st_bf4(P + (size_t)r * 256 + bj * 128 + wc * 32 + n * 16 + fq * 4, acc[ai][bj][m][n] * inv);
        __builtin_amdgcn_sched_barrier(0); }
  }
  asm volatile("s_waitcnt vmcnt(0)" ::: "memory");
  auto epi = [=](int row, int c0, f32x4 v0, f32x4 v1) -> float {
    st_bf4(p.ob + (size_t)(R0 + row) * 1024 + h * 256 + c0, v0); st_bf4(p.ob + (size_t)(R0 + row) * 1024 + h * 256 + c0 + 128, v1); return 0.f; };
  big_tile<false, 0>(lds, P, 256, p.vT + (size_t)(b * 4 + h) * 65536, 256, 256, 0, 0, nullptr, epi);
}

__device__ __forceinline__ void attn_sample_unit(LAS float* L, const Params& p, int unit) {
  const int b = unit >> 2, h = unit & 3, tid = threadIdx.x, wid = tid >> 6, lane = tid & 63, lg = lane >> 4, li = lane & 15;
  LAS float* S = L;
  LAS float* Pm = L + 1024;
  LAS float* Op = L + 2048;
  const float* Kc = p.cache_k + (size_t)b * 256 * 1024 + h * 256;
  const float* Vc = p.cache_v + (size_t)b * 256 * 1024 + h * 256;
  f32x4 q[4][4];
#pragma unroll
  for (int tq = 0; tq < 4; ++tq)
#pragma unroll
    for (int jj = 0; jj < 4; ++jj) q[tq][jj] = ld_bf4(p.qb + (size_t)(NP + b * 4 + tq) * 1024 + h * 256 + jj * 64 + li * 4);
  __syncthreads();
#pragma unroll 4
  for (int itr = 0; itr < 8; ++itr) {
    const int m = wid * 32 + itr * 4 + lg;
    f32x4 kv[4];
#pragma unroll
    for (int jj = 0; jj < 4; ++jj) kv[jj] = __builtin_nontemporal_load((const f32x4*)(Kc + (size_t)m * 1024 + jj * 64 + li * 4));
#pragma unroll
    for (int tq = 0; tq < 4; ++tq) {
      float d = 0.f;
#pragma unroll
      for (int jj = 0; jj < 4; ++jj) d += q[tq][jj][0] * kv[jj][0] + q[tq][jj][1] * kv[jj][1] + q[tq][jj][2] * kv[jj][2] + q[tq][jj][3] * kv[jj][3];
      d += __shfl_xor(d, 1); d += __shfl_xor(d, 2); d += __shfl_xor(d, 4); d += __shfl_xor(d, 8);
      if (li == 0) S[tq * 256 + m] = d * 0.0625f;
    }
  }
  f32x4 vpre[16];
#pragma unroll
  for (int mi = 0; mi < 16; ++mi) vpre[mi] = __builtin_nontemporal_load((const f32x4*)(Vc + (size_t)(wid * 32 + mi) * 1024 + lane * 4));
  __syncthreads();
  if (wid < 4) {
    float s[4]; float mx = -3.0e38f;
#pragma unroll
    for (int i = 0; i < 4; ++i) { s[i] = S[wid * 256 + i * 64 + lane]; mx = fmaxf(mx, s[i]); }
    mx = wave_max(mx); float sum = 0.f;
#pragma unroll
    for (int i = 0; i < 4; ++i) { s[i] = __expf(s[i] - mx); sum += s[i]; }
    sum = wave_sum(sum); const float inv = 1.f / sum;
#pragma unroll
    for (int i = 0; i < 4; ++i) Pm[wid * 256 + i * 64 + lane] = s[i] * inv;
  }
  f32x4 vpost[16];
#pragma unroll
  for (int mi = 0; mi < 16; ++mi) vpost[mi] = __builtin_nontemporal_load((const f32x4*)(Vc + (size_t)(wid * 32 + 16 + mi) * 1024 + lane * 4));
  __syncthreads();
  f32x4 o[4];
#pragma unroll
  for (int tq = 0; tq < 4; ++tq) o[tq] = (f32x4){0.f, 0.f, 0.f, 0.f};
#pragma unroll
  for (int mi = 0; mi < 16; ++mi) {
    const int m = wid * 32 + mi;
#pragma unroll
    for (int tq = 0; tq < 4; ++tq) o[tq] += vpre[mi] * Pm[tq * 256 + m];
  }
#pragma unroll
  for (int mi = 0; mi < 16; ++mi) {
    const int m = wid * 32 + 16 + mi;
#pragma unroll
    for (int tq = 0; tq < 4; ++tq) o[tq] += vpost[mi] * Pm[tq * 256 + m];
  }
#pragma unroll
  for (int tq = 0; tq < 4; ++tq) *(LAS f32x4*)(Op + (wid * 4 + tq) * 256 + lane * 4) = o[tq];
  __syncthreads();
#pragma unroll
  for (int i = 0; i < 2; ++i) {
    const int idx = tid + i * 512, tq = idx >> 8, d = idx & 255; float s = 0.f;
#pragma unroll
    for (int w = 0; w < 8; ++w) s += Op[(w * 4 + tq) * 256 + d];
    p.ob[(size_t)(NP + b * 4 + tq) * 1024 + h * 256 + d] = f2bf(s);
  }
}

__device__ __forceinline__ void phase8(LAS unsigned char* lds, const Params& p) {
  const bool pf = ((blockIdx.x >> 3) & 1) != 0;
  if (pf) for (int it = blockIdx.x; it < 256; it += gridDim.x) attn_prompt_unit(lds, p, it);
  for (int it = blockIdx.x; it < 512; it += gridDim.x) attn_sample_unit((LAS float*)lds, p, it);
  if (!pf) for (int it = blockIdx.x; it < 256; it += gridDim.x) attn_prompt_unit(lds, p, it);
}

template <bool PRE>
__device__ __forceinline__ void p11_tile(LAS unsigned char* lds, const Params& p, int pm, int pn, bool has_next, int pm2, int pn2) {
  __syncthreads();
  f32x4 acc[2][2][4][2];
  gemm_core<PRE>(lds, p.x2b + (size_t)pm * 256 * 1024, 1024, p.WguT + (size_t)pn * 256 * 1024, 1024, 1024, acc);
  int tid = threadIdx.x; asm volatile("" : "+v"(tid));
  const int wid = tid >> 6, lane = tid & 63, wr = wid >> 2, wc = wid & 3, fr = lane & 15, fq = lane >> 4;
  float rs[2][4];
#pragma unroll
  for (int ai = 0; ai < 2; ++ai)
#pragma unroll
    for (int m = 0; m < 4; ++m) rs[ai][m] = p.rstd2[pm * 256 + ai * 128 + wr * 64 + m * 16 + fr];
  asm volatile("s_waitcnt vmcnt(0)" ::: "memory");
  if (has_next) gemm_prestage(lds, p.x2b + (size_t)pm2 * 256 * 1024, 1024, p.WguT + (size_t)pn2 * 256 * 1024, 1024);
#pragma unroll
  for (int ai = 0; ai < 2; ++ai)
#pragma unroll
    for (int m = 0; m < 4; ++m) {
      const int row = pm * 256 + ai * 128 + wr * 64 + m * 16 + fr; const float r_ = rs[ai][m];
      f32x4 o0, o1;
#pragma unroll
      for (int j = 0; j < 4; ++j) { o0[j] = siluf_(acc[ai][0][m][0][j] * r_) * (acc[ai][1][m][0][j] * r_); o1[j] = siluf_(acc[ai][0][m][1][j] * r_) * (acc[ai][1][m][1][j] * r_); }
      u32x4 ov = {pack2(o0[0], o0[1]), pack2(o0[2], o0[3]), pack2(o1[0], o1[1]), pack2(o1[2], o1[3])};
      *(u32x4*)(p.actb + (size_t)row * DFF + pn * 128 + wc * 32 + fq * 8) = ov;
      __builtin_amdgcn_sched_barrier(0);
    }
}
__device__ __forceinline__ void phase11(LAS unsigned char* lds, const Params& p) {
  bool pre = false;
  for (int r = 0; r * (int)gridDim.x < 66 * 22; ++r) {
    const int it = xcd_tile_id(r);
    if (it >= 66 * 22) break;
    int pm, pn; tile_pmn(it, 66, 22, 4, pm, pn);
    const int it2 = xcd_tile_id(r + 1); const bool has_next = it2 < 66 * 22;
    int pm2 = 0, pn2 = 0; if (has_next) tile_pmn(it2, 66, 22, 4, pm2, pn2);
    if (pre) p11_tile<true>(lds, p, pm, pn, has_next, pm2, pn2); else p11_tile<false>(lds, p, pm, pn, has_next, pm2, pn2);
    pre = has_next;
  }
}

template <int PH>
__device__ __forceinline__ void run_phase(LAS unsigned char* lds, const Params& p) {
  if constexpr (PH == 0) phase0(lds, p);
  else if constexpr (PH == 1) phase1(lds, p);
  else if constexpr (PH == 2) phase2(lds, p);
  else if constexpr (PH == 3) phase3(lds, p);
  else if constexpr (PH == 4) phase4(lds, p);
  else if constexpr (PH == 5 || PH == 9 || PH == 12) {
    auto epi = [=](int row, int c0, f32x4 v0, f32x4 v1) -> float {
      st_bf4(p.gob + (size_t)row * 1024 + c0, v0); st_bf4(p.gob + (size_t)row * 1024 + c0 + 128, v1); return sq4(v0) + sq4(v1); };
    auto epi8 = [=](int row, int c0, f32x4 a0, f32x4 a1, f32x4 b0, f32x4 b1) -> float {
      st_bf8(p.gob + (size_t)row * 1024 + c0, a0, a1); st_bf8(p.gob + (size_t)row * 1024 + c0 + 128, b0, b1); return sq4(a0) + sq4(a1) + sq4(b0) + sq4(b1); };
    if constexpr (PH == 5) gemm_n1024<true>(lds, p, p.mix, 1024, p.WoutT, 1024, epi, epi8);
    else if constexpr (PH == 9) gemm_n1024<true>(lds, p, p.ob, 1024, p.WoT, 1024, epi, epi8);
    else gemm_n1024<true>(lds, p, p.actb, DFF, p.WdT, DFF, epi, epi8);
  }
  else if constexpr (PH == 6) resid_phase<1>(p);
  else if constexpr (PH == 7) {
    auto epi = [=](int row, int c0, f32x4 v0, f32x4 v1) -> float {
      const float rs = p.rstd1[row]; st_bf4(p.qb + (size_t)row * 1024 + c0, v0 * rs); st_bf4(p.qb + (size_t)row * 1024 + c0 + 128, v1 * rs); return 0.f; };
    auto epi8 = [=](int row, int c0, f32x4 a0, f32x4 a1, f32x4 b0, f32x4 b1) -> float {
      const float rs = p.rstd1[row]; st_bf8(p.qb + (size_t)row * 1024 + c0, a0 * rs, a1 * rs); st_bf8(p.qb + (size_t)row * 1024 + c0 + 128, b0 * rs, b1 * rs); return 0.f; };
    gemm_n1024<false>(lds, p, p.x1b, 1024, p.WqT, 1024, epi, epi8);
  }
  else if constexpr (PH == 8) phase8(lds, p);
  else if constexpr (PH == 10) resid_phase<2>(p);
  else if constexpr (PH == 11) phase11(lds, p);
  else if constexpr (PH == 13) resid_phase<3>(p);
}

#if MEGA
#ifndef PROBE_MASK
#define PROBE_MASK 0
#endif
#define XB_TMO      128
#define XB_XCNT(j)  (256  + 64 * (j))
#define XB_XSUB(j)  (1280 + 64 * (j))
#define XB_XGEN(j)  (2304 + 64 * (j))
#define XB_TOP      3328
#define XB_TOPGEN   3392
#define XCD_BAR_WORDS 3456
#define XB_SPIN_CAP (1u << 18)
__device__ __forceinline__ unsigned xb_ld(unsigned* p)              { return __hip_atomic_load(p, __ATOMIC_RELAXED, __HIP_MEMORY_SCOPE_AGENT); }
__device__ __forceinline__ unsigned xb_add(unsigned* p, unsigned v) { return __hip_atomic_fetch_add(p, v, __ATOMIC_RELAXED, __HIP_MEMORY_SCOPE_AGENT); }
__device__ __forceinline__ unsigned xb_xcc_id() { return (unsigned)__builtin_amdgcn_s_getreg((3 << 11) | 20) & 0xFu; }
#define XB_SPIN(cond, bar) do { unsigned _sp = 0; while (cond) { __builtin_amdgcn_s_sleep(1); \
    if ((++_sp & 255u) == 0u) { if (xb_ld(&(bar)[XB_TMO])) break; if (_sp > XB_SPIN_CAP) { atomicAdd(&(bar)[XB_TMO], 1u); break; } } } } while (0)
struct XcdBarrier { unsigned* bar; unsigned x; volatile LAS unsigned* st; };
__device__ __forceinline__ XcdBarrier xcd_barrier_post(unsigned* bar, volatile LAS unsigned* st) {
  XcdBarrier b; b.bar = bar; b.x = xb_xcc_id(); b.st = st;
  if (threadIdx.x == 0) (void)xb_add(&bar[XB_XCNT(b.x)], 1u);
  return b;
}
__device__ __forceinline__ void xcd_barrier_complete(unsigned* bar, unsigned x, unsigned& nloc, unsigned& nx) {
  const unsigned G = gridDim.x * gridDim.y * gridDim.z;
  unsigned sum, cnt, mine, sp = 0u;
  for (;;) {
    sum = 0u; cnt = 0u; mine = 0u;
#pragma unroll
    for (unsigned j = 0; j < 16; ++j) { const unsigned c = xb_ld(&bar[XB_XCNT(j)]); sum += c; cnt += (c > 0u) ? 1u : 0u; mine = (j == x) ? c : mine; }
    if (sum == G) break;
    __builtin_amdgcn_s_sleep(1);
    if ((++sp & 255u) == 0u) { if (xb_ld(&bar[XB_TMO])) break; if (sp > XB_SPIN_CAP) { atomicAdd(&bar[XB_TMO], 1u); break; } }
  }
  nloc = mine > 0u ? mine : 1u; nx = cnt > 0u ? cnt : 1u;
}
__device__ __forceinline__ void xcd_barrier(const XcdBarrier& b) {
  asm volatile("s_waitcnt vmcnt(0)" ::: "memory");
  __syncthreads();
  if (threadIdx.x == 0) {
    unsigned* bar = b.bar;
    __builtin_amdgcn_s_waitcnt(0);
    unsigned nloc = b.st[0], nx = b.st[1];
    if (nloc == 0u) { xcd_barrier_complete(bar, b.x, nloc, nx); b.st[0] = nloc; b.st[1] = nx; }
    const unsigned old = xb_add(&bar[XB_XSUB(b.x)], 1u);
    const unsigned gen = old / nloc;
    if (old + 1u == (gen + 1u) * nloc) {
      __builtin_amdgcn_fence(__ATOMIC_RELEASE, "agent");
      asm volatile("s_waitcnt vmcnt(0)" ::: "memory");
      const unsigned og = xb_add(&bar[XB_TOP], 1u);
      const unsigned tg = og / nx;
      if (og + 1u == (tg + 1u) * nx) xb_add(&bar[XB_TOPGEN], 1u);
      else XB_SPIN(xb_ld(&bar[XB_TOPGEN]) == tg, bar);
      __builtin_amdgcn_fence(__ATOMIC_ACQUIRE, "agent");
      xb_add(&bar[XB_XGEN(b.x)], 1u);
      asm volatile("s_waitcnt vmcnt(0)" ::: "memory");
    } else {
      XB_SPIN(xb_ld(&bar[XB_XGEN(b.x)]) == gen, bar);
      __builtin_amdgcn_fence(__ATOMIC_ACQUIRE, "agent");
      asm volatile("s_waitcnt vmcnt(0)" ::: "memory");
    }
  }
  __syncthreads();
}
#define RUN_PH(ph) do { run_phase<ph>(lds, p); if ((PROBE_MASK >> (ph)) & 1) { xcd_barrier(xb); run_phase<ph>(lds, p); } } while (0)
#define BAR_PH() xcd_barrier(xb)
__global__ void __launch_bounds__(NTHR) k_mega(Params p) {
  extern __shared__ __attribute__((aligned(16))) unsigned char shm[];
  LAS unsigned char* lds = (LAS unsigned char*)shm;
  cg::grid_group grid = cg::this_grid();
  volatile LAS unsigned* xst = (volatile LAS unsigned*)(lds + 8 * HTB);
  if (threadIdx.x == 0) { xst[0] = 0u; xst[1] = 0u; xst[2] = 0u; xst[3] = 0u; }
  __syncthreads();
  const XcdBarrier xb = xcd_barrier_post(p.bar, xst);
  RUN_PH(0);
  if (p.bar == nullptr) grid.sync();
  BAR_PH();
  RUN_PH(1); BAR_PH();
  RUN_PH(2); BAR_PH();
  RUN_PH(4); BAR_PH();
  RUN_PH(5); BAR_PH();
  RUN_PH(6); BAR_PH();
  RUN_PH(7); BAR_PH();
  RUN_PH(8); BAR_PH();
  RUN_PH(9); BAR_PH();
  RUN_PH(10); BAR_PH();
  RUN_PH(11); BAR_PH();
  RUN_PH(12); BAR_PH();
  RUN_PH(13);
}
#else
template <int PH>
__global__ void __launch_bounds__(NTHR) k_phase(Params p) {
  extern __shared__ __attribute__((aligned(16))) unsigned char shm[];
  run_phase<PH>((LAS unsigned char*)shm, p);
}
template <int PH>
static void launch_phase(const Params& p, hipStream_t stream) {
  static bool attr = false;
  if (!attr) { (void)hipFuncSetAttribute((const void*)k_phase<PH>, hipFuncAttributeMaxDynamicSharedMemorySize, LDS_BYTES); attr = true; }
  hipLaunchKernelGGL(k_phase<PH>, dim3(256), dim3(NTHR), LDS_BYTES, stream, p);
}
#endif

extern "C" void kernel_launch(void* const* d_in, const int* in_sizes, int n_in, void* d_out, int out_size, void* d_ws, size_t ws_size, hipStream_t stream) {
  Params p{};
  const float** ins = (const float**)&p.x_prompt;
  for (int i = 0; i < 32; ++i) ins[i] = (const float*)d_in[i];
  float* o = (float*)d_out;
  p.y = o; o += (size_t)NTOK * 1024;
  p.memk = o; o += 2097152; p.memv = o; o += 2097152;
  p.convp = o; o += 122880; p.sre_p = o; o += 16384; p.sim_p = o; o += 16384;
  p.convs = o; o += 1966080; p.sre_s = o; o += 262144; p.sim_s = o;
  char* w = (char*)d_ws; size_t off = 0;
  auto take = [&](size_t bytes) { char* r = w + off; off += (bytes + 255) & ~(size_t)255; return r; };
  char* r1 = take((size_t)NTOK * DFF * 2 + (size_t)16 * 1024 * 1024);
  {
    size_t o1 = 0; auto t1 = [&](size_t bytes) { char* r = r1 + o1; o1 += (bytes + 255) & ~(size_t)255; return r; };
    p.xb = (bf16_t*)t1((size_t)NTOK * 1024 * 2);
    p.vbuf = (bf16_t*)t1((size_t)NTOK * 512 * 2);
    p.A2 = (bf16_t*)t1((size_t)32 * 1024 * 384 * 2);
    p.Sst = (float*)t1((size_t)32 * 1024 * 128 * 4);
    p.yact = (bf16_t*)t1((size_t)NTOK * 512 * 2);
    p.actb = (bf16_t*)r1;
  }
  p.memb = (bf16_t*)take((size_t)2048 * 1024 * 2);
  p.WinT = (bf16_t*)take((size_t)1536 * 1024 * 2);
  p.WkvT = (bf16_t*)take((size_t)2048 * 1024 * 2);
  p.WgluT = (bf16_t*)take((size_t)512 * 512 * 2);
  p.WoutT = (bf16_t*)take((size_t)1024 * 1024 * 2);
  p.WqT = (bf16_t*)take((size_t)1024 * 1024 * 2);
  p.WoT = (bf16_t*)take((size_t)1024 * 1024 * 2);
  p.WguT = (bf16_t*)take((size_t)5632 * 1024 * 2);
  p.WdT = (bf16_t*)take((size_t)1024 * DFF * 2);
  p.TY = (bf16_t*)take((size_t)32 * 256 * 384 * 2);
  p.ST = (bf16_t*)take((size_t)32 * 256 * 256 * 2);
  p.mix = (bf16_t*)take((size_t)NTOK * 1024 * 2);
  p.Pscr = p.mix;
  p.gob = (bf16_t*)take((size_t)NTOK * 1024 * 2);
  p.x1b = (bf16_t*)take((size_t)NTOK * 1024 * 2);
  p.qb = (bf16_t*)take((size_t)NTOK * 1024 * 2);
  p.kb = (bf16_t*)take((size_t)8 * 4 * 256 * 256 * 2);
  p.vT = (bf16_t*)take((size_t)8 * 4 * 256 * 256 * 2);
  p.ob = (bf16_t*)take((size_t)NTOK * 1024 * 2);
  p.x2b = (bf16_t*)take((size_t)NTOK * 1024 * 2);
  p.rstd0 = (float*)take((size_t)NTOK * 4); p.rstdm = (float*)take(2048 * 4);
  p.abar = (float*)take(32 * 64 * 2 * 4); p.a16 = (float*)take(32 * 64 * 2 * 4);
  p.Bbre = (float*)take(32 * 64 * 16 * 4); p.Bbim = (float*)take(32 * 64 * 16 * 4);
  p.usamp = (float*)take((size_t)512 * 512 * 4);
  p.ssq = (float*)take((size_t)16 * NTOK * 4);
  p.rstd1 = (float*)take((size_t)NTOK * 4); p.rstd2 = (float*)take((size_t)NTOK * 4);
  p.bar = (unsigned*)take(XCD_BAR_WORDS * 4);
  p.apw = (float*)take((size_t)32 * 2176 * 4); p.Ktab = (float*)take((size_t)32 * 4096 * 4);
  if (off > ws_size) { fprintf(stderr, "workspace too small: need %zu have %zu\n", off, ws_size); return; }
#if MEGA
  static int grid_blocks = 0;
  if (!grid_blocks) {
    (void)hipFuncSetAttribute((const void*)k_mega, hipFuncAttributeMaxDynamicSharedMemorySize, LDS_BYTES);
    int dev = 0, cus = 0, per_cu = 0;
    (void)hipGetDevice(&dev);
    (void)hipDeviceGetAttribute(&cus, hipDeviceAttributeMultiprocessorCount, dev);
    (void)hipOccupancyMaxActiveBlocksPerMultiprocessor(&per_cu, (const void*)k_mega, NTHR, LDS_BYTES);
    if (per_cu < 1) per_cu = 1;
    grid_blocks = cus;
  }
  (void)hipMemsetAsync(p.bar, 0, XCD_BAR_WORDS * 4, stream);
  void* args[] = {&p};
  hipError_t e = hipLaunchCooperativeKernel((const void*)k_mega, dim3(grid_blocks), dim3(NTHR), args, LDS_BYTES, stream);
  if (e != hipSuccess) fprintf(stderr, "cooperative launch failed: %s (grid %d)\n", hipGetErrorString(e), grid_blocks);
#else
  launch_phase<0>(p, stream); launch_phase<1>(p, stream); launch_phase<2>(p, stream); launch_phase<3>(p, stream);
  launch_phase<4>(p, stream); launch_phase<5>(p, stream); launch_phase<6>(p, stream); launch_phase<7>(p, stream);
  launch_phase<8>(p, stream); launch_phase<9>(p, stream); launch_phase<10>(p, stream); launch_phase<11>(p, stream);
  launch_phase<12>(p, stream); launch_phase<13>(p, stream);
#endif
}
```

```cpp
#include <hip/hip_runtime.h>
#include <hip/hip_cooperative_groups.h>
#include <cstdio>
#include <cstdint>
namespace cg = cooperative_groups;

#ifndef MEGA
#define MEGA 1
#endif

#define LAS __attribute__((address_space(3)))
typedef unsigned short bf16_t;
typedef short bf16x8 __attribute__((ext_vector_type(8)));
typedef float f32x4 __attribute__((ext_vector_type(4)));
typedef float f32x16 __attribute__((ext_vector_type(16)));
typedef unsigned u32x2 __attribute__((ext_vector_type(2)));

constexpr int NP = 16384, NS = 512, NTOK = NP + NS, DM = 1024, DC = 512, DFF = 2816;
constexpr int HTB = 128 * 64 * 2;
constexpr int LDS_BYTES = 8 * HTB + 8192;
constexpr int NTHR = 512;

struct Params {
  const float *x_prompt, *x_sample, *mem_prompt, *cache_k, *cache_v, *state_conv, *st_re, *st_im, *norm_g, *mem_norm_g,
      *w_in, *w_dw, *b_dw, *ln_g, *ln_b, *lam_re, *lam_im, *log_dt, *b_re, *b_im, *c_re, *c_im, *d_skip, *w_glu, *w_out,
      *w_q, *w_k, *w_v, *w_o, *w_gate, *w_up, *w_down;
  float *y, *memk, *memv, *convp, *sre_p, *sim_p, *convs, *sre_s, *sim_s;
  bf16_t *xb, *memb, *WinT, *WkvT, *WgluT, *WoutT, *WqT, *WoT, *WguT, *WdT, *TY, *ST, *vbuf, *A2, *yact, *mix, *gob, *x1b,
      *qb, *kb, *vT, *Pscr, *ob, *x2b, *actb;
  float *rstd0, *rstdm, *abar, *a16, *Bbre, *Bbim, *usamp, *Sst, *ssq, *rstd1, *rstd2;
  float *apw, *Ktab;
  unsigned* bar;
};

__device__ __forceinline__ bf16_t f2bf(float f) { unsigned r; asm("v_cvt_pk_bf16_f32 %0, %1, %1" : "=v"(r) : "v"(f)); return (bf16_t)(r & 0xffffu); }
__device__ __forceinline__ float bf2f(bf16_t h) { return __uint_as_float(((unsigned)h) << 16); }
__device__ __forceinline__ unsigned pack2(float a, float b) { unsigned r; asm("v_cvt_pk_bf16_f32 %0, %1, %2" : "=v"(r) : "v"(a), "v"(b)); return r; }
__device__ __forceinline__ void st_bf4(bf16_t* p, f32x4 v) { u32x2 o; o.x = pack2(v[0], v[1]); o.y = pack2(v[2], v[3]); *(u32x2*)p = o; }
typedef unsigned u32x4_ __attribute__((ext_vector_type(4)));
__device__ __forceinline__ void st_bf8(bf16_t* p, f32x4 a, f32x4 b) { u32x4_ o = {pack2(a[0], a[1]), pack2(a[2], a[3]), pack2(b[0], b[1]), pack2(b[2], b[3])}; *(u32x4_*)p = o; }
__device__ __forceinline__ f32x4 ld_bf4(const bf16_t* p) { u32x2 o = *(const u32x2*)p; f32x4 v; v[0] = __uint_as_float(o.x << 16); v[1] = __uint_as_float(o.x & 0xffff0000u); v[2] = __uint_as_float(o.y << 16); v[3] = __uint_as_float(o.y & 0xffff0000u); return v; }
__device__ __forceinline__ f32x4 ld_bf4_nt(const bf16_t* p) { u32x2 o = __builtin_nontemporal_load((const u32x2*)p); f32x4 v; v[0] = __uint_as_float(o.x << 16); v[1] = __uint_as_float(o.x & 0xffff0000u); v[2] = __uint_as_float(o.y << 16); v[3] = __uint_as_float(o.y & 0xffff0000u); return v; }
__device__ __forceinline__ float sigmoidf_(float x) { return __builtin_amdgcn_rcpf(1.f + __expf(-x)); }
__device__ __forceinline__ float siluf_(float x) { return x * sigmoidf_(x); }
__device__ __forceinline__ float gelu_tanh(float y) { float z = 0.7978845608028654f * (y + 0.044715f * y * y * y); float t = 1.f - 2.f * __builtin_amdgcn_rcpf(1.f + __expf(2.f * z)); return 0.5f * y * (1.f + t); }
__device__ __forceinline__ int tid_opq() { int t = threadIdx.x; asm volatile("" : "+v"(t)); return t; }
__device__ __forceinline__ float sq4(f32x4 v) { return v[0] * v[0] + v[1] * v[1] + v[2] * v[2] + v[3] * v[3]; }
__device__ __forceinline__ float wave_sum(float v) { for (int o = 32; o > 0; o >>= 1) v += __shfl_xor(v, o); return v; }
__device__ __forceinline__ float wave_max(float v) { for (int o = 32; o > 0; o >>= 1) v = fmaxf(v, __shfl_xor(v, o)); return v; }

__device__ __forceinline__ int lds_byte(int r, int c) { const int st = (r >> 4) * 2 + (c >> 5), rr = r & 15, cc = c & 31, ob = rr * 64 + cc * 2; return st * 1024 + (ob ^ (((ob >> 9) & 1) << 5)); }
__device__ __forceinline__ void stage_rc(int b, int& R, int& C) { const int st = b / 1024, sb = b % 1024, swz = sb ^ (((sb >> 9) & 1) << 5); R = (st >> 1) * 16 + swz / 64; C = (st & 1) * 32 + (swz % 64) / 2; }

#define G_SA(b, h) (((b) * 2 + (h)) * HTB)
#define G_SB(b, h) ((4 + (b) * 2 + (h)) * HTB)
#define G_STAGE(bufoff, gbase, voff) do { _Pragma("unroll") for (int _i = 0; _i < 2; ++_i) \
    __builtin_amdgcn_global_load_lds((const unsigned*)((const char*)(gbase) + (voff)[_i]), (LAS unsigned*)(lds + (bufoff) + ldsw + _i * 8192), 16, 0, 0); } while (0)
#define G_LDA(dst, b, h) do { _Pragma("unroll") for (int m = 0; m < 4; ++m) _Pragma("unroll") for (int k = 0; k < 2; ++k) dst[m][k] = *(const LAS bf16x8*)(lds + G_SA(b, h) + aoff + m * 2048 + k * 1024); } while (0)
#define G_LDB(dst, b, h) do { _Pragma("unroll") for (int n = 0; n < 2; ++n) _Pragma("unroll") for (int k = 0; k < 2; ++k) dst[n][k] = *(const LAS bf16x8*)(lds + G_SB(b, h) + boff + n * 2048 + k * 1024); } while (0)
#define G_MMA(ai, bj, At, Bt) do { __builtin_amdgcn_s_setprio(1); _Pragma("unroll") for (int m = 0; m < 4; ++m) _Pragma("unroll") for (int n = 0; n < 2; ++n) _Pragma("unroll") for (int k = 0; k < 2; ++k) \
    acc[ai][bj][m][n] = __builtin_amdgcn_mfma_f32_16x16x32_bf16(Bt[n][k], At[m][k], acc[ai][bj][m][n], 0, 0, 0); __builtin_amdgcn_s_setprio(0); } while (0)
#define G_WAIT_V(n) asm volatile("s_waitcnt vmcnt(" #n ")" ::: "memory")
#define G_WAIT_L(n) asm volatile("s_waitcnt lgkmcnt(" #n ")" ::: "memory")
#define G_BAR __builtin_amdgcn_s_barrier()
#define G_SCHED __builtin_amdgcn_sched_barrier(0)

template <bool PRE = false>
__device__ __forceinline__ void gemm_core(LAS unsigned char* lds, const bf16_t* A, int lda, const bf16_t* Bt, int ldb, int K, f32x4 (&acc)[2][2][4][2]) {
  int tid = threadIdx.x; asm volatile("" : "+v"(tid));
  const int wid = __builtin_amdgcn_readfirstlane(tid >> 6), lane = tid & 63, wr = wid >> 2, wc = wid & 3, fr = lane & 15, fq = lane >> 4;
  unsigned voffA[2], voffB[2];
#pragma unroll
  for (int i = 0; i < 2; ++i) { int R, C; stage_rc(tid * 16 + i * 8192, R, C); voffA[i] = (unsigned)(R * lda + C) * 2u; voffB[i] = (unsigned)(R * ldb + C) * 2u; }
  const size_t hA = (size_t)128 * lda * 2, hB = (size_t)128 * ldb * 2;
  const unsigned ldsw = (unsigned)wid * 1024u;
  const int aoff = lds_byte(wr * 64 + fr, fq * 8), boff = lds_byte(wc * 32 + fr, fq * 8);
  const char* cA = (const char*)A; const char* cB = (const char*)Bt;
#pragma unroll
  for (int a = 0; a < 2; ++a)
#pragma unroll
    for (int b = 0; b < 2; ++b)
#pragma unroll
      for (int m = 0; m < 4; ++m)
#pragma unroll
        for (int n = 0; n < 2; ++n) acc[a][b][m][n] = (f32x4){0.f, 0.f, 0.f, 0.f};
  bf16x8 At[4][2], B0[2][2], B1[2][2];
  const int nt = K / 64;
  if (!PRE) {
    G_STAGE(G_SB(0, 0), cB, voffB); G_STAGE(G_SA(0, 0), cA, voffA); G_STAGE(G_SB(0, 1), cB + hB, voffB); G_STAGE(G_SA(0, 1), cA + hA, voffA);
    if (wr == 1) G_BAR;
    G_WAIT_V(4); G_BAR;
  } else {
    if (wr == 1) G_BAR;
    G_WAIT_V(0); G_BAR;
  }
  G_STAGE(G_SB(1, 0), cB + 128, voffB); G_STAGE(G_SA(1, 0), cA + 128, voffA); G_STAGE(G_SB(1, 1), cB + hB + 128, voffB);
  G_WAIT_V(6); G_BAR;
  for (int t = 0; t < nt - 2; t += 2) {
    const char* a1 = cA + (size_t)(t + 1) * 128; const char* a2 = cA + (size_t)(t + 2) * 128; const char* b2 = cB + (size_t)(t + 2) * 128;
    const char* a3 = a2 + 128; const char* b3 = b2 + 128;
    G_LDB(B0, 0, 0); G_SCHED; G_LDA(At, 0, 0); G_STAGE(G_SA(1, 1), a1 + hA, voffA);
    G_WAIT_L(8); G_BAR; G_WAIT_L(0); G_MMA(0, 0, At, B0); G_BAR; G_SCHED;
    G_LDB(B1, 0, 1); G_STAGE(G_SB(0, 0), b2, voffB);
    G_BAR; G_WAIT_L(0); G_MMA(0, 1, At, B1); G_BAR;
    G_LDA(At, 0, 1); G_STAGE(G_SA(0, 0), a2, voffA);
    G_BAR; G_WAIT_L(0); G_MMA(1, 0, At, B0); G_BAR; G_SCHED;
    G_STAGE(G_SB(0, 1), b2 + hB, voffB);
    G_WAIT_V(6); G_BAR; G_MMA(1, 1, At, B1); G_BAR;
    G_LDB(B0, 1, 0); G_SCHED; G_LDA(At, 1, 0); G_STAGE(G_SA(0, 1), a2 + hA, voffA);
    G_WAIT_L(8); G_BAR; G_WAIT_L(0); G_MMA(0, 0, At, B0); G_BAR; G_SCHED;
    G_LDB(B1, 1, 1); G_STAGE(G_SB(1, 0), b3, voffB);
    G_BAR; G_WAIT_L(0); G_MMA(0, 1, At, B1); G_BAR;
    G_LDA(At, 1, 1); G_STAGE(G_SA(1, 0), a3, voffA);
    G_BAR; G_WAIT_L(0); G_MMA(1, 0, At, B0); G_BAR; G_SCHED;
    G_STAGE(G_SB(1, 1), b3 + hB, voffB);
    G_WAIT_V(6); G_BAR; G_MMA(1, 1, At, B1); G_BAR;
  }
  { const char* al = cA + (size_t)(nt - 1) * 128;
    G_LDB(B0, 0, 0); G_LDA(At, 0, 0); G_STAGE(G_SA(1, 1), al + hA, voffA);
    G_BAR; G_WAIT_L(0); G_MMA(0, 0, At, B0); G_BAR;
    G_LDB(B1, 0, 1); G_BAR; G_WAIT_L(0); G_MMA(0, 1, At, B1); G_BAR;
    G_LDA(At, 0, 1); G_WAIT_V(4); G_BAR; G_WAIT_L(0); G_MMA(1, 0, At, B0); G_MMA(1, 1, At, B1); G_BAR; }
  { G_LDB(B0, 1, 0); G_LDA(At, 1, 0); G_WAIT_V(2); G_BAR; G_WAIT_L(0); G_MMA(0, 0, At, B0); G_BAR;
    G_LDB(B1, 1, 1); G_WAIT_V(0); G_BAR; G_WAIT_L(0); G_MMA(0, 1, At, B1); G_BAR;
    G_LDA(At, 1, 1); G_BAR; G_WAIT_L(0); G_MMA(1, 0, At, B0); G_MMA(1, 1, At, B1); G_BAR; }
  if (wr == 0) G_BAR;
}

__device__ __forceinline__ void gemm_prestage(LAS unsigned char* lds, const bf16_t* A, int lda, const bf16_t* Bt, int ldb) {
  int tid = threadIdx.x; asm volatile("" : "+v"(tid));
  const int wid = __builtin_amdgcn_readfirstlane(tid >> 6);
  unsigned voffA[2], voffB[2];
#pragma unroll
  for (int i = 0; i < 2; ++i) { int R, C; stage_rc(tid * 16 + i * 8192, R, C); voffA[i] = (unsigned)(R * lda + C) * 2u; voffB[i] = (unsigned)(R * ldb + C) * 2u; }
  const size_t hA = (size_t)128 * lda * 2, hB = (size_t)128 * ldb * 2;
  const unsigned ldsw = (unsigned)wid * 1024u;
  const char* cA = (const char*)A; const char* cB = (const char*)Bt;
  G_STAGE(G_SB(0, 0), cB, voffB); G_STAGE(G_SA(0, 0), cA, voffA); G_STAGE(G_SB(0, 1), cB + hB, voffB); G_STAGE(G_SA(0, 1), cA + hA, voffA);
}

__device__ __forceinline__ int xcd_tile_id(int r) { const int per = gridDim.x >> 3; return (r * 8 + (blockIdx.x & 7)) * per + (blockIdx.x >> 3); }
__device__ __forceinline__ void tile_pmn(int id, int nM, int nN, int GM, int& pm, int& pn) {
  const int per = GM * nN, grp = id / per, within = id - grp * per, gsz = (nM - grp * GM) < GM ? (nM - grp * GM) : GM;
  pn = within / gsz; pm = grp * GM + within - pn * gsz;
}

template <bool SSQ, int MODE, class Epi>
__device__ __forceinline__ void big_tile(LAS unsigned char* lds, const bf16_t* A, int lda, const bf16_t* Bt, int ldb, int K, int rowbase, int colbase, float* ssqp, Epi epi) {
  __syncthreads();
  f32x4 acc[2][2][4][2];
  gemm_core(lds, A, lda, Bt, ldb, K, acc);
  int tid = threadIdx.x; asm volatile("" : "+v"(tid));
  const int wid = tid >> 6, lane = tid & 63, wr = wid >> 2, wc = wid & 3, fr = lane & 15, fq = lane >> 4;
#pragma unroll
  for (int ai = 0; ai < 2; ++ai)
#pragma unroll
    for (int m = 0; m < 4; ++m) {
      const int row = rowbase + ai * 128 + wr * 64 + m * 16 + fr; float ss = 0.f;
#pragma unroll
      for (int n = 0; n < 2; ++n) if constexpr (MODE != 2) ss += epi(row, colbase + wc * 32 + (MODE == 1 ? fq * 8 + n * 4 : n * 16 + fq * 4), acc[ai][0][m][n], acc[ai][1][m][n]);
      if constexpr (MODE == 2) ss += epi(row, colbase + wc * 32 + fq * 8, acc[ai][0][m][0], acc[ai][0][m][1], acc[ai][1][m][0], acc[ai][1][m][1]);
      if (SSQ) { ss += __shfl_xor(ss, 16); ss += __shfl_xor(ss, 32); if (fq == 0) ssqp[(size_t)wc * NTOK + row] = ss; }
      __builtin_amdgcn_sched_barrier(0);
    }
}

template <bool SSQ, class Epi>
__device__ __forceinline__ void small_tile(const bf16_t* A, int lda, const bf16_t* B0, int ldb, int K, int rowbase, int colbase, float* ssqp, Epi epi) {
  const int lane = threadIdx.x & 63, r = lane & 31, h = lane >> 5;
  const bf16_t* pa = A + (size_t)r * lda + h * 8; const bf16_t* pb0 = B0 + (size_t)r * ldb + h * 8; const bf16_t* pb1 = pb0 + (size_t)128 * ldb;
  f32x16 c0, c1;
#pragma unroll
  for (int i = 0; i < 16; ++i) { c0[i] = 0.f; c1[i] = 0.f; }
#pragma unroll 4
  for (int k = 0; k < K; k += 16) {
    bf16x8 a = *(const bf16x8*)(pa + k), b0 = *(const bf16x8*)(pb0 + k), b1 = *(const bf16x8*)(pb1 + k);
    c0 = __builtin_amdgcn_mfma_f32_32x32x16_bf16(b0, a, c0, 0, 0, 0);
    c1 = __builtin_amdgcn_mfma_f32_32x32x16_bf16(b1, a, c1, 0, 0, 0);
  }
  float ss = 0.f;
#pragma unroll
  for (int q4 = 0; q4 < 4; ++q4) {
    f32x4 v0 = {c0[4 * q4], c0[4 * q4 + 1], c0[4 * q4 + 2], c0[4 * q4 + 3]}, v1 = {c1[4 * q4], c1[4 * q4 + 1], c1[4 * q4 + 2], c1[4 * q4 + 3]};
    ss += epi(rowbase + r, colbase + 8 * q4 + 4 * h, v0, v1);
  }
  if (SSQ) { ss += __shfl_xor(ss, 32); if (h == 0) ssqp[rowbase + r] = ss; }
}

__device__ __forceinline__ void p0_s5tables(LAS float* L, const Params& p, int g) {
  const int tid = threadIdx.x;
  LAS float* apr = L;
  LAS float* api = L + 1088;
  LAS float* bbr = L + 2176;
  LAS float* bbi = L + 3200;
  LAS float* cre = L + 4224;
  LAS float* cim = L + 5248;
  __syncthreads();
  if (tid < 64) {
    const int n = tid;
    float brow[16], birow[16];
#pragma unroll
    for (int q4 = 0; q4 < 4; ++q4) { const f32x4 a = *(const f32x4*)(p.b_re + (g * 64 + n) * 16 + q4 * 4), b = *(const f32x4*)(p.b_im + (g * 64 + n) * 16 + q4 * 4);
#pragma unroll
      for (int j = 0; j < 4; ++j) { brow[q4 * 4 + j] = a[j]; birow[q4 * 4 + j] = b[j]; } }
    const double lr = (double)p.lam_re[g * 64 + n], li = (double)p.lam_im[g * 64 + n], dt = exp((double)p.log_dt[g]);
    const double er = exp(lr * dt), ar = er * cos(li * dt), ai = er * sin(li * dt);
    const double den = lr * lr + li * li, cr = ((ar - 1.0) * lr + ai * li) / den, ci = (ai * lr - (ar - 1.0) * li) / den;
    double pr = 1.0, pi = 0.0;
    for (int j = 0; j <= 16; ++j) { apr[j * 64 + n] = (float)pr; api[j * 64 + n] = (float)pi; const double nr = pr * ar - pi * ai, ni = pr * ai + pi * ar; pr = nr; pi = ni; }
    p.abar[(g * 64 + n) * 2] = (float)ar; p.abar[(g * 64 + n) * 2 + 1] = (float)ai;
    p.a16[(g * 64 + n) * 2] = apr[16 * 64 + n]; p.a16[(g * 64 + n) * 2 + 1] = api[16 * 64 + n];
#pragma unroll
    for (int q = 0; q < 16; ++q) {
      const double br = (double)brow[q], bi = (double)birow[q];
      const float xr = (float)(cr * br - ci * bi), xi = (float)(cr * bi + ci * br);
      bbr[n * 16 + q] = xr; bbi[n * 16 + q] = xi; p.Bbre[(g * 64 + n) * 16 + q] = xr; p.Bbim[(g * 64 + n) * 16 + q] = xi;
    }
  }
  for (int i = tid; i < 1024; i += NTHR) { cre[i] = p.c_re[g * 1024 + i]; cim[i] = p.c_im[g * 1024 + i]; }
  __syncthreads();
  for (int i = tid; i < 1088; i += NTHR) { p.apw[(size_t)g * 2176 + i] = apr[i]; p.apw[(size_t)g * 2176 + 1088 + i] = api[i]; }
  if (tid < 256) {
    const int pp = tid >> 4, q = tid & 15; float kacc[16];
#pragma unroll
    for (int j = 0; j < 16; ++j) kacc[j] = 0.f;
    for (int n = 0; n < 64; ++n) {
      const float ar = apr[64 + n], ai = api[64 + n], cr_ = cre[pp * 64 + n], ci_ = cim[pp * 64 + n], br = bbr[n * 16 + q], bi = bbi[n * 16 + q];
      float er = cr_ * br - ci_ * bi, ei = cr_ * bi + ci_ * br;
#pragma unroll
      for (int j = 0; j < 16; ++j) { kacc[j] += er; const float nr = er * ar - ei * ai, ni = er * ai + ei * ar; er = nr; ei = ni; }
    }
    const float dsk = (pp == q) ? p.d_skip[g * 16 + pp] : 0.f;
#pragma unroll
    for (int j = 0; j < 16; ++j) p.Ktab[(size_t)g * 4096 + (j << 8) + tid] = kacc[j] + (j == 0 ? dsk : 0.f);
  }
}

typedef unsigned u32x4 __attribute__((ext_vector_type(4)));
__device__ __forceinline__ void p1_s5mats(LAS float* L, const Params& p, int g) {
  const int tid = threadIdx.x;
  LAS float* apr = L;
  LAS float* api = L + 1088;
  LAS float* bbr = L + 2176;
  LAS float* bbi = L + 3200;
  LAS float* cre = L + 4224;
  LAS float* cim = L + 5248;
  LAS float* Kt = L + 6272;
  __syncthreads();
  for (int i = tid; i < 1088; i += NTHR) { apr[i] = p.apw[(size_t)g * 2176 + i]; api[i] = p.apw[(size_t)g * 2176 + 1088 + i]; }
  for (int i = tid; i < 1024; i += NTHR) { bbr[i] = p.Bbre[g * 1024 + i]; bbi[i] = p.Bbim[g * 1024 + i]; cre[i] = p.c_re[g * 1024 + i]; cim[i] = p.c_im[g * 1024 + i]; }
  for (int i = tid; i < 4096; i += NTHR) Kt[i] = p.Ktab[(size_t)g * 4096 + i];
  __syncthreads();
  bf16_t* TY = p.TY + (size_t)g * 256 * 384;
  for (int ch = tid; ch < 256 * 48; ch += NTHR) {
    const int row = ch / 48, k0 = (ch - row * 48) * 8, t = row >> 4, pp = row & 15; float v[8];
    if (k0 < 256) { const int s_ = k0 >> 4, q0 = k0 & 15;
#pragma unroll
      for (int j = 0; j < 8; ++j) v[j] = (s_ <= t) ? Kt[((t - s_) << 8) + (pp << 4) + q0 + j] : 0.f; }
    else if (k0 < 320) {
#pragma unroll
      for (int j = 0; j < 8; ++j) { const int n = k0 - 256 + j; v[j] = cre[pp * 64 + n] * apr[(t + 1) * 64 + n] - cim[pp * 64 + n] * api[(t + 1) * 64 + n]; } }
    else {
#pragma unroll
      for (int j = 0; j < 8; ++j) { const int n = k0 - 320 + j; v[j] = -(cre[pp * 64 + n] * api[(t + 1) * 64 + n] + cim[pp * 64 + n] * apr[(t + 1) * 64 + n]); } }
    u32x4 o = {pack2(v[0], v[1]), pack2(v[2], v[3]), pack2(v[4], v[5]), pack2(v[6], v[7])};
    *(u32x4*)(TY + (size_t)row * 384 + k0) = o;
  }
  bf16_t* ST = p.ST + (size_t)g * 256 * 256;
  for (int ch = tid; ch < 256 * 32; ch += NTHR) {
    const int row = ch >> 5, k0 = (ch & 31) * 8, s_ = k0 >> 4, q0 = k0 & 15; float v[8];
#pragma unroll
    for (int j = 0; j < 8; ++j) v[j] = 0.f;
    if (row < 128) { const int n = row & 63; const float pr = apr[(15 - s_) * 64 + n], pi = api[(15 - s_) * 64 + n];
#pragma unroll
      for (int j = 0; j < 8; ++j) { const float br = bbr[n * 16 + q0 + j], bi = bbi[n * 16 + q0 + j]; v[j] = (row < 64) ? (pr * br - pi * bi) : (pr * bi + pi * br); } }
    u32x4 o = {pack2(v[0], v[1]), pack2(v[2], v[3]), pack2(v[4], v[5]), pack2(v[6], v[7])};
    *(u32x4*)(ST + (size_t)row * 256 + k0) = o;
  }
}

__device__ __forceinline__ void p0_transpose4(LAS float* L, const float* src, int N, int Kd, const float* scale, bf16_t* dst, int tk, int tn4, int mode) {
  const int tid = threadIdx.x;
  f32x4 v[4][2]; float sc[2];
#pragma unroll
  for (int i = 0; i < 2; ++i) { const int kk = (tid >> 4) + i * 32; sc[i] = scale ? scale[tk * 64 + kk] : 1.f;
#pragma unroll
    for (int u = 0; u < 4; ++u) v[u][i] = *(const f32x4*)(src + (size_t)(tk * 64 + kk) * N + (tn4 * 4 + u) * 64 + (tid & 15) * 4); }
  __syncthreads();
#pragma unroll
  for (int u = 0; u < 4; ++u)
#pragma unroll
    for (int i = 0; i < 2; ++i) { const int kk = (tid >> 4) + i * 32, nn = (tid & 15) * 4; LAS float* T = L + u * 4160 + kk * 65 + nn;
      T[0] = v[u][i][0] * sc[i]; T[1] = v[u][i][1] * sc[i]; T[2] = v[u][i][2] * sc[i]; T[3] = v[u][i][3] * sc[i]; }
  __syncthreads();
  const int nl = tid >> 3, k0 = (tid & 7) * 8;
#pragma unroll
  for (int u = 0; u < 4; ++u) {
    const int n = (tn4 * 4 + u) * 64 + nl; int drow;
    if (mode == 0) drow = n;
    else if (mode == 1) drow = (n < 512) ? ((n >> 7) * 256 + (n & 127)) : (n < 1024 ? (((n - 512) >> 7) * 256 + 128 + (n & 127)) : n);
    else if (mode == 2) drow = (n >> 7) * 256 + (n & 127);
    else drow = (n >> 7) * 256 + 128 + (n & 127);
    drow = (drow & ~31) + (((drow >> 2) & 1) << 4) + (((drow >> 3) & 3) << 2) + (drow & 3);
    LAS float* T = L + u * 4160;
    u32x4 ov = {pack2(T[(k0 + 0) * 65 + nl], T[(k0 + 1) * 65 + nl]), pack2(T[(k0 + 2) * 65 + nl], T[(k0 + 3) * 65 + nl]),
                pack2(T[(k0 + 4) * 65 + nl], T[(k0 + 5) * 65 + nl]), pack2(T[(k0 + 6) * 65 + nl], T[(k0 + 7) * 65 + nl])};
    *(u32x4*)(dst + (size_t)drow * Kd + tk * 64 + k0) = ov;
  }
}

__device__ __forceinline__ void p0_rowcvt4(const float* src, bf16_t* dst, float* rstd) {
  const int lane = threadIdx.x & 63; f32x4 v[4][4];
#pragma unroll
  for (int r = 0; r < 4; ++r)
#pragma unroll
    for (int i = 0; i < 4; ++i) v[r][i] = *(const f32x4*)(src + (size_t)r * 1024 + i * 256 + lane * 4);
#pragma unroll
  for (int r = 0; r < 4; ++r) { float ss = 0.f;
#pragma unroll
    for (int i = 0; i < 4; ++i) { ss += sq4(v[r][i]); st_bf4(dst + (size_t)r * 1024 + i * 256 + lane * 4, v[r][i]); }
    ss = wave_sum(ss); if (lane == 0) rstd[r] = rsqrtf(ss * (1.f / 1024.f) + 1e-6f); }
}

__device__ __forceinline__ void transpose_item(LAS float* L, const Params& p, int j) {
  const float* src; int N, Kd, mode; const float* sc; bf16_t* dst;
  if (j < 96) { src = p.w_in; N = 1536; Kd = 1024; sc = p.norm_g; dst = p.WinT; mode = 1; }
  else if ((j -= 96) < 64) { src = p.w_k; N = 1024; Kd = 1024; sc = p.mem_norm_g; dst = p.WkvT; mode = 0; }
  else if ((j -= 64) < 64) { src = p.w_v; N = 1024; Kd = 1024; sc = p.mem_norm_g; dst = p.WkvT + (size_t)1024 * 1024; mode = 0; }
  else if ((j -= 64) < 16) { src = p.w_glu; N = 512; Kd = 512; sc = nullptr; dst = p.WgluT; mode = 0; }
  else if ((j -= 16) < 64) { src = p.w_out; N = 1024; Kd = 1024; sc = nullptr; dst = p.WoutT; mode = 0; }
  else if ((j -= 64) < 64) { src = p.w_q; N = 1024; Kd = 1024; sc = p.norm_g + 2 * 1024; dst = p.WqT; mode = 0; }
  else if ((j -= 64) < 64) { src = p.w_o; N = 1024; Kd = 1024; sc = nullptr; dst = p.WoT; mode = 0; }
  else if ((j -= 64) < 176) { src = p.w_gate; N = 2816; Kd = 1024; sc = p.norm_g + 4 * 1024; dst = p.WguT; mode = 2; }
  else if ((j -= 176) < 176) { src = p.w_up; N = 2816; Kd = 1024; sc = p.norm_g + 4 * 1024; dst = p.WguT; mode = 3; }
  else { j -= 176; src = p.w_down; N = 1024; Kd = 2816; sc = nullptr; dst = p.WdT; mode = 0; }
  const int nN4 = N / 256, tk = j / nN4, tn4 = j - tk * nN4;
  p0_transpose4(L, src, N, Kd, sc, dst, tk, tn4, mode);
}

__device__ __forceinline__ void phase0(LAS unsigned char* lds, const Params& p) {
  LAS float* L = (LAS float*)lds;
  const int wid = threadIdx.x >> 6;
  constexpr int T_S5 = 32, T_TR = 240, T_ROW = NTOK / 32 + 2048 / 32;
  if (blockIdx.x < T_S5) { p0_s5tables(L, p, blockIdx.x); asm volatile("s_waitcnt vmcnt(0)" ::: "memory"); p1_s5mats(L, p, blockIdx.x); return; }
  for (int it = blockIdx.x - T_S5; it < T_TR + T_ROW; it += gridDim.x - T_S5) {
    int j = it;
    if (j < T_TR) { transpose_item(L, p, j); continue; }
    j -= T_TR;
    if (j < NTOK / 32) { const int row = j * 32 + wid * 4; const float* src = row < NP ? p.x_prompt + (size_t)row * 1024 : p.x_sample + (size_t)(row - NP) * 1024;
      p0_rowcvt4(src, p.xb + (size_t)row * 1024, p.rstd0 + row); }
    else { const int row = (j - NTOK / 32) * 32 + wid * 4; p0_rowcvt4(p.mem_prompt + (size_t)row * 1024, p.memb + (size_t)row * 1024, p.rstdm + row); }
  }
}

__device__ __forceinline__ void phase1(LAS unsigned char* lds, const Params& p) {
  for (int r = 0; r * (int)gridDim.x < 66 * 6 + 64 + 32; ++r) {
    const int it = xcd_tile_id(r);
    if (it >= 66 * 6 + 64 + 32) continue;
    if (it >= 460) {
      int pm, pn; tile_pmn(it - 460, 4, 8, 4, pm, pn);
      auto epi = [=](int row, int c0, f32x4 v0, f32x4 v1) -> float {
#pragma unroll
        for (int hf = 0; hf < 2; ++hf) {
          const int c = c0 + hf * 128; f32x4 v = hf ? v1 : v0; const f32x4 rs = *(const f32x4*)(p.rstdm + c);
          const int rt = (row & ~31) + 8 * ((row >> 2) & 3) + 4 * ((row >> 4) & 1) + (row & 3);
          st_bf4(p.vT + ((size_t)((c >> 8) * 4 + (rt >> 8)) * 256 + (rt & 255)) * 256 + (c & 255), v * rs);
        }
        return 0.f; };
      big_tile<false, 0>(lds, p.WkvT + (size_t)(1024 + pm * 256) * 1024, 1024, p.memb + (size_t)pn * 256 * 1024, 1024, 1024, pm * 256, pn * 256, nullptr, epi);
      continue;
    }
    if (it < 396) {
      int pm, pn; tile_pmn(it, 66, 6, 4, pm, pn);
      auto epi = [=](int row, int c0, f32x4 a0, f32x4 a1, f32x4 b0, f32x4 b1) -> float {
        const float rs = p.rstd0[row];
        if (pn < 4) {
          const int c = pn * 128 + (c0 & 127); f32x4 o0, o1;
#pragma unroll
          for (int j = 0; j < 4; ++j) { o0[j] = (a0[j] * rs) * sigmoidf_(b0[j] * rs); o1[j] = (a1[j] * rs) * sigmoidf_(b1[j] * rs); }
          st_bf8(p.vbuf + (size_t)row * 512 + c, o0, o1);
          if (row < NP) { const int t = row & 2047; if (t >= 2018) { float* d = p.convp + ((size_t)(row >> 11) * 30 + (t - 2018)) * 512 + c; *(f32x4*)d = o0; *(f32x4*)(d + 4) = o1; } }
          else { const int sr = row - NP; float* d = p.convs + ((size_t)(sr >> 2) * 30 + 26 + (sr & 3)) * 512 + c; *(f32x4*)d = o0; *(f32x4*)(d + 4) = o1; }
        } else {
#pragma unroll
          for (int hf = 0; hf < 2; ++hf) {
            const int cc = (c0 - 1024) + hf * 128; f32x4 v0 = hf ? b0 : a0, v1 = hf ? b1 : a1; v0 *= rs; v1 *= rs;
            if (row < NP) { const int g = cc >> 4, pp = cc & 15, b = row >> 11, t = row & 2047;
              st_bf8(p.A2 + ((size_t)g * 1024 + b * 128 + (t >> 4)) * 384 + (t & 15) * 16 + pp, v0, v1); }
            else { float* d = p.usamp + (size_t)(row - NP) * 512 + cc; *(f32x4*)d = v0; *(f32x4*)(d + 4) = v1; }
          }
        }
        return 0.f; };
      big_tile<false, 2>(lds, p.xb + (size_t)pm * 256 * 1024, 1024, p.WinT + (size_t)pn * 256 * 1024, 1024, 1024, pm * 256, pn * 256, nullptr, epi);
    } else {
      int pm, pn; tile_pmn(it - 396, 8, 8, 4, pm, pn);
      auto epi = [=](int row, int c0, f32x4 a0, f32x4 a1, f32x4 b0, f32x4 b1) -> float {
        const float rs = p.rstdm[row]; const int b = row >> 8, mm = row & 255;
#pragma unroll
        for (int hf = 0; hf < 2; ++hf) {
          const int c = c0 + hf * 128; f32x4 v0 = hf ? b0 : a0, v1 = hf ? b1 : a1; v0 *= rs; v1 *= rs;
          if (c < 1024) { float* d = p.memk + (size_t)row * 1024 + c; *(f32x4*)d = v0; *(f32x4*)(d + 4) = v1; st_bf8(p.kb + ((size_t)(b * 4 + (c >> 8)) * 256 + mm) * 256 + (c & 255), v0, v1); }
          else { float* d = p.memv + (size_t)row * 1024 + (c - 1024); *(f32x4*)d = v0; *(f32x4*)(d + 4) = v1; }
        }
        return 0.f; };
      big_tile<false, 2>(lds, p.memb + (size_t)pm * 256 * 1024, 1024, p.WkvT + (size_t)pn * 256 * 1024, 1024, 1024, pm * 256, pn * 256, nullptr, epi);
    }
  }
}

template <int TT, bool SAMPLE>
__device__ __forceinline__ void conv_tile(LAS float* L, const Params& p, int idx) {
  const int c = tid_opq(), wid = c >> 6, lane = c & 63;
  constexpr int NV = TT + 30;
  float vals[NV];
  int R0;
  if (!SAMPLE) {
    const int b = idx / (2048 / TT), t0 = (idx % (2048 / TT)) * TT; R0 = b * 2048 + t0;
#pragma unroll
    for (int j = 0; j < NV; ++j) { const int tt = t0 - 30 + j; const float v = bf2f(p.vbuf[(size_t)(b * 2048 + (tt < 0 ? 0 : tt)) * 512 + c]); vals[j] = tt < 0 ? 0.f : v; }
  } else {
    R0 = NP + idx * 4;
#pragma unroll
    for (int j = 0; j < 30; ++j) vals[j] = p.state_conv[((size_t)idx * 30 + j) * 512 + c];
#pragma unroll
    for (int j = 0; j < TT; ++j) vals[30 + j] = bf2f(p.vbuf[(size_t)(R0 + j) * 512 + c]);
#pragma unroll
    for (int i = 0; i < 26; ++i) p.convs[((size_t)idx * 30 + i) * 512 + c] = vals[i + 4];
  }
  float o[TT]; const float bias = p.b_dw[c];
#pragma unroll
  for (int i = 0; i < TT; ++i) o[i] = bias;
  float wk[31];
#pragma unroll
  for (int k = 0; k < 31; ++k) wk[k] = p.w_dw[k * 512 + c];
#pragma unroll
  for (int k = 0; k < 31; ++k) {
#pragma unroll
    for (int i = 0; i < TT; ++i) o[i] += wk[k] * vals[i + k]; }
  __syncthreads();
  if constexpr (TT == 32) {
    float v[64];
#pragma unroll
    for (int i = 0; i < 32; ++i) { v[i] = o[i]; v[32 + i] = o[i] * o[i]; }
#pragma unroll
    for (int st = 0; st < 6; ++st) {
      const int off = 32 >> st, nn = 32 >> st; const bool up = (lane & off) != 0;
#pragma unroll
      for (int i = 0; i < nn; ++i) { const float send = up ? v[i] : v[i + nn], keep = up ? v[i + nn] : v[i]; v[i] = keep + __shfl_xor(send, off); }
    }
    L[wid * 64 + lane] = v[0];
    __syncthreads();
    if (wid == 0) { float t = 0.f;
#pragma unroll
      for (int w = 0; w < 8; ++w) t += L[w * 64 + lane];
      L[512 + lane] = t; }
    __syncthreads();
  } else {
#pragma unroll
    for (int i = 0; i < TT; ++i) { const float s1 = wave_sum(o[i]), s2 = wave_sum(o[i] * o[i]); if (lane == 0) { L[wid * 64 + i] = s1; L[wid * 64 + 32 + i] = s2; } }
    __syncthreads();
    if (wid == 0) { float t = 0.f;
#pragma unroll
      for (int w = 0; w < 8; ++w) t += L[w * 64 + lane];
      L[512 + lane] = t; }
    __syncthreads();
  }
  const float lg = p.ln_g[c], lb = p.ln_b[c];
#pragma unroll
  for (int i = 0; i < TT; ++i) {
    const float mean = L[512 + i] * (1.f / 512.f), var = fmaxf(L[512 + 32 + i] * (1.f / 512.f) - mean * mean, 0.f);
    const float r = rsqrtf(var + 1e-5f);
    p.mix[(size_t)(R0 + i) * 1024 + c] = f2bf(siluf_((o[i] - mean) * r * lg + lb)); }
}

constexpr int CV_IN = 4096, CV_OUT = 69632;
__device__ __forceinline__ void convp_gload(const Params& p, int idx, int tid, u32x4_ (&g)[8]) {
  const int b = idx >> 6, t0 = (idx & 63) * 32;
#pragma unroll
  for (int i = 0; i < 8; ++i) {
    int ch = tid + i * 512; ch = ch < 3968 ? ch : 3967;
    const int j = ch >> 6, k = ch & 63, tt = t0 - 30 + j;
    u32x4_ v = *(const u32x4_*)(p.vbuf + (size_t)(b * 2048 + (tt < 0 ? 0 : tt)) * 512 + k * 8);
    if (tt < 0) v = (u32x4_){0u, 0u, 0u, 0u};
    g[i] = v;
  }
}
__device__ __forceinline__ void convp_stage(LAS unsigned char* lds, int tid, const u32x4_ (&g)[8], float (&vals)[62]) {
#pragma unroll
  for (int i = 0; i < 8; ++i) { const int ch = tid + i * 512; if (ch < 3968) *(LAS u32x4_*)(lds + CV_IN + ch * 16) = g[i]; }
  __syncthreads();
#pragma unroll
  for (int j = 0; j < 62; ++j) vals[j] = bf2f(*(const LAS unsigned short*)(lds + CV_IN + j * 1024 + tid * 2));
}
__device__ __forceinline__ void convp_fma(const float (&vals)[62], const float (&wk)[31], float bias, float (&o)[32]) {
#pragma unroll
  for (int i = 0; i < 32; ++i) o[i] = bias;
#pragma unroll
  for (int k = 0; k < 31; ++k) {
#pragma unroll
    for (int i = 0; i < 32; ++i) o[i] += wk[k] * vals[i + k]; }
}
__device__ __forceinline__ void convp_finish(LAS unsigned char* lds, const Params& p, int idx, int c, const float (&o)[32], float lg, float lb) {
  LAS float* L = (LAS float*)lds;
  const int wid = c >> 6, lane = c & 63, R0 = (idx >> 6) * 2048 + (idx & 63) * 32;
  __syncthreads();
  float v[64];
#pragma unroll
  for (int i = 0; i < 32; ++i) { v[i] = o[i]; v[32 + i] = o[i] * o[i]; }
#pragma unroll
  for (int st = 0; st < 6; ++st) {
    const int off = 32 >> st, nn = 32 >> st; const bool up = (lane & off) != 0;
#pragma unroll
    for (int i = 0; i < nn; ++i) { const float send = up ? v[i] : v[i + nn], keep = up ? v[i + nn] : v[i]; v[i] = keep + __shfl_xor(send, off); }
  }
  L[wid * 64 + lane] = v[0];
  __syncthreads();
  if (wid == 0) { float t = 0.f;
#pragma unroll
    for (int w = 0; w < 8; ++w) t += L[w * 64 + lane];
    L[512 + lane] = t; }
  __syncthreads();
#pragma unroll
  for (int i = 0; i < 32; ++i) {
    const float mean = L[512 + i] * (1.f / 512.f), var = fmaxf(L[512 + 32 + i] * (1.f / 512.f) - mean * mean, 0.f);
    const float r = rsqrtf(var + 1e-5f);
    *(LAS unsigned short*)(lds + CV_OUT + i * 1024 + c * 2) = f2bf(siluf_((o[i] - mean) * r * lg + lb)); }
  __syncthreads();
#pragma unroll
  for (int i = 0; i < 4; ++i) { const int ch = c + i * 512, row = ch >> 6, k = ch & 63;
    *(u32x4_*)(p.mix + (size_t)(R0 + row) * 1024 + k * 8) = *(const LAS u32x4_*)(lds + CV_OUT + ch * 16); }
}

__device__ __forceinline__ void s5_sample_item(LAS float* L, const Params& p, int item) {
  const int g = item & 31, bc = item >> 5, tid = tid_opq(), wid = tid >> 6, lane = tid & 63, n = lane;
  LAS float* cre = L;
  LAS float* cim = L + 1040;
  LAS float* hL = L + 2080 + wid * 520;
  LAS float* uL = L + 2080 + 8 * 520 + wid * 64;
  __syncthreads();
  for (int i = tid; i < 1024; i += NTHR) { const int pp = i >> 6, nn = i & 63; cre[pp * 65 + nn] = p.c_re[g * 1024 + i]; cim[pp * 65 + nn] = p.c_im[g * 1024 + i]; }
  float br[16], bi[16];
#pragma unroll
  for (int q = 0; q < 16; ++q) { br[q] = p.Bbre[(g * 64 + n) * 16 + q]; bi[q] = p.Bbim[(g * 64 + n) * 16 + q]; }
  const float ar = p.abar[(g * 64 + n) * 2], ai = p.abar[(g * 64 + n) * 2 + 1];
  const float dsk = p.d_skip[g * 16 + (lane & 15)];
  __syncthreads();
  for (int ub = 0; ub < 2; ++ub) {
    const int b = bc * 16 + wid * 2 + ub, unit = b * 32 + g;
    const float uval = p.usamp[(size_t)(b * 4 + (lane >> 4)) * 512 + g * 16 + (lane & 15)];
    uL[lane] = uval;
    float hr = p.st_re[(size_t)unit * 64 + n], hi = p.st_im[(size_t)unit * 64 + n];
    __builtin_amdgcn_wave_barrier();
#pragma unroll
    for (int t = 0; t < 4; ++t) {
      float sr = 0.f, si = 0.f;
#pragma unroll
      for (int q = 0; q < 16; ++q) { const float u = uL[t * 16 + q]; sr += br[q] * u; si += bi[q] * u; }
      const float nr = ar * hr - ai * hi + sr, ni = ar * hi + ai * hr + si; hr = nr; hi = ni;
      hL[t * 130 + 2 * n] = hr; hL[t * 130 + 2 * n + 1] = hi;
    }
    p.sre_s[(size_t)unit * 64 + n] = hr; p.sim_s[(size_t)unit * 64 + n] = hi;
    __builtin_amdgcn_wave_barrier();
    const int t = lane >> 4, pp = lane & 15; float y = 0.f;
#pragma unroll 8
    for (int n2 = 0; n2 < 64; ++n2) y += cre[pp * 65 + n2] * hL[t * 130 + 2 * n2] - cim[pp * 65 + n2] * hL[t * 130 + 2 * n2 + 1];
    y += dsk * uval;
    p.yact[(size_t)(NP + b * 4 + t) * 512 + g * 16 + pp] = f2bf(gelu_tanh(y));
    __builtin_amdgcn_wave_barrier();
  }
}

__device__ __forceinline__ void s5_prompt_tile(LAS unsigned char* lds, const Params& p, int it) {
  const int g = it >> 2, pm = it & 3; const int tid = tid_opq();
  {
    auto epi = [=](int row, int c0, f32x4 v0, f32x4 v1) -> float { *(f32x4*)(p.Sst + ((size_t)g * 1024 + row) * 128 + c0) = v0; return 0.f; };
    big_tile<false, 0>(lds, p.A2 + ((size_t)g * 1024 + pm * 256) * 384, 384, p.ST + (size_t)g * 256 * 256, 256, 256, pm * 256, 0, nullptr, epi);
  }
  asm volatile("s_waitcnt vmcnt(0)" ::: "memory");
  __syncthreads();
  {
    LAS float* E = (LAS float*)lds;
    const int q = tid >> 7, bb = (tid >> 6) & 1, b = pm * 2 + bb, n = tid & 63;
    const float ar = p.a16[(g * 64 + n) * 2], ai = p.a16[(g * 64 + n) * 2 + 1];
    const float* S = p.Sst + ((size_t)g * 1024 + b * 128 + q * 32) * 128 + n;
    bf16_t* H = p.A2 + ((size_t)g * 1024 + b * 128 + q * 32) * 384 + 256 + n;
    float sr[32], si[32];
#pragma unroll
    for (int j = 0; j < 32; ++j) { sr[j] = S[(size_t)j * 128]; si[j] = S[(size_t)j * 128 + 64]; }
    float hr = 0.f, hi = 0.f;
#pragma unroll
    for (int j = 0; j < 32; ++j) { const float xr = sr[j], xi = si[j]; sr[j] = hr; si[j] = hi; const float nr = ar * hr - ai * hi + xr, ni = ar * hi + ai * hr + xi; hr = nr; hi = ni; }
    __syncthreads();
    E[(q * 128 + (tid & 127)) * 2] = hr; E[(q * 128 + (tid & 127)) * 2 + 1] = hi;
    float pr = ar, pi = ai;
#pragma unroll
    for (int k = 0; k < 5; ++k) { const float nr = pr * pr - pi * pi, ni = 2.f * pr * pi; pr = nr; pi = ni; }
    __syncthreads();
    float cr = 0.f, ci = 0.f;
    for (int qq = 0; qq < q; ++qq) { const float er = E[(qq * 128 + (tid & 127)) * 2], ei = E[(qq * 128 + (tid & 127)) * 2 + 1];
      const float nr = pr * cr - pi * ci + er, ni = pr * ci + pi * cr + ei; cr = nr; ci = ni; }
    float wr_ = cr, wi_ = ci;
#pragma unroll
    for (int j = 0; j < 32; ++j) {
      H[(size_t)j * 384] = f2bf(sr[j] + wr_); H[(size_t)j * 384 + 64] = f2bf(si[j] + wi_);
      const float nr = ar * wr_ - ai * wi_, ni = ar * wi_ + ai * wr_; wr_ = nr; wi_ = ni;
    }
    if (q == 3) { p.sre_p[(size_t)(b * 32 + g) * 64 + n] = hr + wr_; p.sim_p[(size_t)(b * 32 + g) * 64 + n] = hi + wi_; }
  }
  asm volatile("s_waitcnt vmcnt(0)" ::: "memory");
  __syncthreads();
  auto epi = [=](int row, int c0, f32x4 v0, f32x4 v1) -> float {
#pragma unroll
    for (int hf = 0; hf < 2; ++hf) {
      const int col = c0 + hf * 128, t = col >> 4, pp = col & 15; f32x4 v = hf ? v1 : v0; f32x4 o;
#pragma unroll
      for (int j = 0; j < 4; ++j) o[j] = gelu_tanh(v[j]);
      st_bf4(p.yact + ((size_t)row * 16 + t) * 512 + g * 16 + pp, o);
    }
    return 0.f; };
  big_tile<false, 0>(lds, p.A2 + ((size_t)g * 1024 + pm * 256) * 384, 384, p.TY + (size_t)g * 256 * 384, 384, 384, pm * 256, 0, nullptr, epi);
  __syncthreads();
}

__device__ __forceinline__ void phase2(LAS unsigned char* lds, const Params& p) {
  LAS float* L = (LAS float*)lds;
  volatile LAS int* slot = (volatile LAS int*)(lds + 8 * HTB + 64);
  constexpr int T_CP = 512, T_S5 = 256, T_CS = 128;
  if (blockIdx.x < 128) s5_prompt_tile(lds, p, blockIdx.x);
  const int c = tid_opq();
  float wk[31]; u32x4_ g[8];
#pragma unroll
  for (int k = 0; k < 31; ++k) wk[k] = p.w_dw[k * 512 + c];
  const float bias = p.b_dw[c], lg = p.ln_g[c], lb = p.ln_b[c];
  unsigned pend = 0u;
  auto grab_issue = [&]() { if (threadIdx.x == 0) pend = __hip_atomic_fetch_add(p.bar, 1u, __ATOMIC_RELAXED, __HIP_MEMORY_SCOPE_AGENT); };
  auto grab_collect = [&]() -> int {
    __syncthreads();
    if (threadIdx.x == 0) *slot = (int)pend;
    __syncthreads();
    return *slot; };
  grab_issue();
  int cur = grab_collect(); bool loaded = false;
  while (cur < T_CP + T_S5 + T_CS) {
    grab_issue();
    int nxt;
    if (cur < T_CP) {
      if (!loaded) convp_gload(p, cur, c, g);
      float vals[62], o[32];
      convp_stage(lds, c, g, vals);
      convp_fma(vals, wk, bias, o);
      nxt = grab_collect();
      loaded = nxt < T_CP; if (loaded) convp_gload(p, nxt, c, g);
      convp_finish(lds, p, cur, c, o, lg, lb);
    } else {
      if (cur < T_CP + T_S5) s5_sample_item(L, p, cur - T_CP);
      else conv_tile<4, true>(L, p, cur - T_CP - T_S5);
      nxt = grab_collect();
    }
    cur = nxt;
  }
}

__device__ __forceinline__ void phase3(LAS unsigned char* lds, const Params& p) {}

__device__ __forceinline__ void phase4(LAS unsigned char* lds, const Params& p) {
  {
    const int id0 = xcd_tile_id(0);
    if (id0 >= 132) { for (int j = 240 + (id0 - 132); j < 960; j += (int)gridDim.x - 132) transpose_item((LAS float*)lds, p, j); return; }
  }
  for (int r = 0; r * (int)gridDim.x < 132; ++r) {
    const int it = xcd_tile_id(r);
    if (it >= 132) continue;
    int pm, pn; tile_pmn(it, 66, 2, 16, pm, pn);
    auto epi = [=](int row, int c0, f32x4 a0, f32x4 a1, f32x4 b0, f32x4 b1) -> float {
#pragma unroll
      for (int hf = 0; hf < 2; ++hf) {
        const int col = c0 + hf * 128; const f32x4 v0 = hf ? b0 : a0, v1 = hf ? b1 : a1;
        const f32x4 y0 = ld_bf4(p.yact + (size_t)row * 512 + col), y1 = ld_bf4(p.yact + (size_t)row * 512 + col + 4); f32x4 o0, o1;
#pragma unroll
        for (int j = 0; j < 4; ++j) { o0[j] = y0[j] * sigmoidf_(v0[j]); o1[j] = y1[j] * sigmoidf_(v1[j]); }
        st_bf8(p.mix + (size_t)row * 1024 + 512 + col, o0, o1);
      }
      return 0.f; };
    big_tile<false, 2>(lds, p.yact + (size_t)pm * 256 * 512, 512, p.WgluT + (size_t)pn * 256 * 512, 512, 512, pm * 256, pn * 256, nullptr, epi);
  }
}

template <bool SSQ, class Epi>
__device__ __forceinline__ void small_tile_sk(LAS float* L, const bf16_t* A, int lda, const bf16_t* B0, int ldb, int K, int rowbase, int colbase, float* ssqp, Epi epi) {
  const int tid = threadIdx.x, wid = tid >> 6, lane = tid & 63, fr = lane & 15, fq = lane >> 4;
  const int kc = K >> 3;
  const bf16_t* pa = A + (size_t)fr * lda + fq * 8 + wid * kc;
  const bf16_t* pb = B0 + (size_t)fr * ldb + fq * 8 + wid * kc;
  f32x4 acc[2][4];
#pragma unroll
  for (int rh = 0; rh < 2; ++rh)
#pragma unroll
    for (int cq = 0; cq < 4; ++cq) acc[rh][cq] = (f32x4){0.f, 0.f, 0.f, 0.f};
#pragma unroll 4
  for (int k = 0; k < kc; k += 32) {
    const bf16x8 a0 = *(const bf16x8*)(pa + k), a1 = *(const bf16x8*)(pa + (size_t)16 * lda + k);
    bf16x8 bq[4];
    bq[0] = *(const bf16x8*)(pb + k); bq[1] = *(const bf16x8*)(pb + (size_t)16 * ldb + k);
    bq[2] = *(const bf16x8*)(pb + (size_t)128 * ldb + k); bq[3] = *(const bf16x8*)(pb + (size_t)144 * ldb + k);
#pragma unroll
    for (int cq = 0; cq < 4; ++cq) {
      acc[0][cq] = __builtin_amdgcn_mfma_f32_16x16x32_bf16(bq[cq], a0, acc[0][cq], 0, 0, 0);
      acc[1][cq] = __builtin_amdgcn_mfma_f32_16x16x32_bf16(bq[cq], a1, acc[1][cq], 0, 0, 0);
    }
  }
  __syncthreads();
#pragma unroll
  for (int rh = 0; rh < 2; ++rh)
#pragma unroll
    for (int cq = 0; cq < 4; ++cq)
#pragma unroll
      for (int j = 0; j < 4; ++j) L[(wid * 32 + (rh * 4 + cq) * 4 + j) * 64 + lane] = acc[rh][cq][j];
  __syncthreads();
  if (wid < 4) {
    const int cql = tid & 1, fq2 = (tid >> 1) & 3, frr = (tid >> 3) & 15, rh = tid >> 7, ls = fq2 * 16 + frr;
    f32x4 v0 = {0.f, 0.f, 0.f, 0.f}, v1 = {0.f, 0.f, 0.f, 0.f};
#pragma unroll
    for (int w = 0; w < 8; ++w)
#pragma unroll
      for (int j = 0; j < 4; ++j) { v0[j] += L[(w * 32 + (rh * 4 + cql) * 4 + j) * 64 + ls]; v1[j] += L[(w * 32 + (rh * 4 + cql + 2) * 4 + j) * 64 + ls]; }
    const int row = rowbase + rh * 16 + frr;
    float ss = epi(row, colbase + 8 * fq2 + 4 * cql, v0, v1);
    if (SSQ) { ss += __shfl_xor(ss, 1); ss += __shfl_xor(ss, 2); ss += __shfl_xor(ss, 4); if ((lane & 7) == 0) ssqp[row] = ss; }
  }
}

template <bool SSQ, class Epi, class Epi8>
__device__ __forceinline__ void gemm_n1024(LAS unsigned char* lds, const Params& p, const bf16_t* A, int lda, const bf16_t* Bt, int K, Epi epi, Epi8 epi8) {
  for (int wt = blockIdx.x; wt < 256; wt += gridDim.x) {
    const int rb = wt & 15, cbk = wt >> 4, pn = cbk >> 2, sub = cbk & 3;
    small_tile_sk<SSQ>((LAS float*)lds, A + (size_t)(NP + rb * 32) * lda, lda, Bt + (size_t)(pn * 256 + sub * 32) * K, K, K, NP + rb * 32, pn * 256 + sub * 32, p.ssq + (size_t)(pn * 4 + sub) * NTOK, epi);
  }
  for (int r = 0; r * (int)gridDim.x < 256; ++r) {
    const int it = xcd_tile_id(r);
    if (it >= 256) continue;
    int pm, pn; tile_pmn(it, 64, 4, 8, pm, pn);
    big_tile<SSQ, 2>(lds, A + (size_t)pm * 256 * lda, lda, Bt + (size_t)pn * 256 * K, K, K, pm * 256, pn * 256, p.ssq + (size_t)(pn * 4) * NTOK, epi8);
  }
}


template <int WHICH>
__device__ __forceinline__ void resid_phase(const Params& p) {
  const int tid = tid_opq(), wid = tid >> 6, lane = tid & 63;
  const float* gain = p.norm_g + (WHICH == 1 ? 1 : (WHICH == 2 ? 3 : 5)) * 1024;
  for (int it = blockIdx.x; it < NTOK / 16; it += gridDim.x) {
    const int row0 = it * 16 + wid * 2;
    float s2[2]; f32x4 xo[2][4], mv[2][4], gv[4];
#pragma unroll
    for (int i = 0; i < 4; ++i) gv[i] = *(const f32x4*)(gain + i * 256 + lane * 4);
#pragma unroll
    for (int r = 0; r < 2; ++r) {
      const int row = row0 + r;
      s2[r] = (lane < 16) ? p.ssq[(size_t)lane * NTOK + row] : 0.f;
#pragma unroll
      for (int i = 0; i < 4; ++i) {
        const int c = i * 256 + lane * 4;
        xo[r][i] = ld_bf4_nt((WHICH == 1 ? p.xb : (WHICH == 2 ? p.x1b : p.x2b)) + (size_t)row * 1024 + c);
        mv[r][i] = ld_bf4_nt(p.gob + (size_t)row * 1024 + c);
      }
    }
#pragma unroll
    for (int r = 0; r < 2; ++r) {
      const int row = row0 + r;
      const float rs = rsqrtf(wave_sum(s2[r]) * (1.f / 1024.f) + 1e-6f);
      float ss = 0.f;
#pragma unroll
      for (int i = 0; i < 4; ++i) { xo[r][i] = xo[r][i] + mv[r][i] * rs * gv[i]; ss += sq4(xo[r][i]); }
      if (WHICH == 3) {
#pragma unroll
        for (int i = 0; i < 4; ++i) *(f32x4*)(p.y + (size_t)row * 1024 + i * 256 + lane * 4) = xo[r][i];
      } else {
        bf16_t* dst = (WHICH == 1 ? p.x1b : p.x2b) + (size_t)row * 1024;
#pragma unroll
        for (int i = 0; i < 4; ++i) st_bf4(dst + i * 256 + lane * 4, xo[r][i]);
        ss = wave_sum(ss);
        if (lane == 0) (WHICH == 1 ? p.rstd1 : p.rstd2)[row] = rsqrtf(ss * (1.f / 1024.f) + 1e-6f);
      }
    }
  }
}

__device__ __forceinline__ void attn_prompt_unit(LAS unsigned char* lds, const Params& p, int u) {
  const int b = u >> 5, h = (u >> 3) & 3, qt = u & 7, R0 = b * 2048 + qt * 256;
  LAS float* red = (LAS float*)lds;
  bf16_t* P = p.Pscr + (size_t)blockIdx.x * 65536;
  __syncthreads();
  {
    f32x4 acc[2][2][4][2];
    gemm_core(lds, p.qb + (size_t)R0 * 1024 + h * 256, 1024, p.kb + (size_t)(b * 4 + h) * 65536, 256, 256, acc);
    int tid = threadIdx.x; asm volatile("" : "+v"(tid));
    const int wid = tid >> 6, lane = tid & 63, wr = wid >> 2, wc = wid & 3, fr = lane & 15, fq = lane >> 4;
    float mx[2][4];
#pragma unroll
    for (int ai = 0; ai < 2; ++ai)
#pragma unroll
      for (int m = 0; m < 4; ++m) { float v = -3.0e38f;
#pragma unroll
        for (int bj = 0; bj < 2; ++bj)
#pragma unroll
          for (int n = 0; n < 2; ++n)
#pragma unroll
            for (int j = 0; j < 4; ++j) v = fmaxf(v, acc[ai][bj][m][n][j]);
        v = fmaxf(v, __shfl_xor(v, 16)); v = fmaxf(v, __shfl_xor(v, 32));
        if (fq == 0) red[wc * 256 + ai * 128 + wr * 64 + m * 16 + fr] = v; __builtin_amdgcn_sched_barrier(0); }
    __syncthreads();
#pragma unroll
    for (int ai = 0; ai < 2; ++ai)
#pragma unroll
      for (int m = 0; m < 4; ++m) { const int r = ai * 128 + wr * 64 + m * 16 + fr; mx[ai][m] = fmaxf(fmaxf(red[r], red[256 + r]), fmaxf(red[512 + r], red[768 + r])); }
    __syncthreads();
#pragma unroll
    for (int ai = 0; ai < 2; ++ai)
#pragma unroll
      for (int m = 0; m < 4; ++m) { float s = 0.f;
#pragma unroll
        for (int bj = 0; bj < 2; ++bj)
#pragma unroll
          for (int n = 0; n < 2; ++n)
#pragma unroll
            for (int j = 0; j < 4; ++j) { const float e = __expf((acc[ai][bj][m][n][j] - mx[ai][m]) * 0.0625f); acc[ai][bj][m][n][j] = e; s += e; }
        s += __shfl_xor(s, 16); s += __shfl_xor(s, 32);
        if (fq == 0) red[wc * 256 + ai * 128 + wr * 64 + m * 16 + fr] = s; __builtin_amdgcn_sched_barrier(0); }
    __syncthreads();
#pragma unroll
    for (int ai = 0; ai < 2; ++ai)
#pragma unroll
      for (int m = 0; m < 4; ++m) { const int r = ai * 128 + wr * 64 + m * 16 + fr; const float inv = 1.f / (red[r] + red[256 + r] + red[512 + r] + red[768 + r]);
#pragma unroll
        for (int bj = 0; bj < 2; ++bj)
#pragma unroll
          for (int n = 0; n < 2; ++n) st_bf4(P + (size_t)r * 256 + bj * 128 + wc * 32 + n * 16 + fq * 4, acc[ai][bj][m][n] * inv);
        __builtin_amdgcn_sched_barrier(0); }
  }
  asm volatile("s_waitcnt vmcnt(0)" ::: "memory");
  auto epi = [=](int row, int c0, f32x4 v0, f32x4 v1) -> float {
    st_bf4(p.ob + (size_t)(R0 + row) * 1024 + h * 256 + c0, v0); st_bf4(p.ob + (size_t)(R0 + row) * 1024 + h * 256 + c0 + 128, v1); return 0.f; };
  big_tile<false, 0>(lds, P, 256, p.vT + (size_t)(b * 4 + h) * 65536, 256, 256, 0, 0, nullptr, epi);
}

__device__ __forceinline__ void attn_sample_unit(LAS float* L, const Params& p, int unit) {
  const int b = unit >> 2, h = unit & 3, tid = threadIdx.x, wid = tid >> 6, lane = tid & 63, lg = lane >> 4, li = lane & 15;
  LAS float* S = L;
  LAS float* Pm = L + 1024;
  LAS float* Op = L + 2048;
  const float* Kc = p.cache_k + (size_t)b * 256 * 1024 + h * 256;
  const float* Vc = p.cache_v + (size_t)b * 256 * 1024 + h * 256;
  f32x4 q[4][4];
#pragma unroll
  for (int tq = 0; tq < 4; ++tq)
#pragma unroll
    for (int jj = 0; jj < 4; ++jj) q[tq][jj] = ld_bf4(p.qb + (size_t)(NP + b * 4 + tq) * 1024 + h * 256 + jj * 64 + li * 4);
  __syncthreads();
#pragma unroll 4
  for (int itr = 0; itr < 8; ++itr) {
    const int m = wid * 32 + itr * 4 + lg;
    f32x4 kv[4];
#pragma unroll
    for (int jj = 0; jj < 4; ++jj) kv[jj] = __builtin_nontemporal_load((const f32x4*)(Kc + (size_t)m * 1024 + jj * 64 + li * 4));
#pragma unroll
    for (int tq = 0; tq < 4; ++tq) {
      float d = 0.f;
#pragma unroll
      for (int jj = 0; jj < 4; ++jj) d += q[tq][jj][0] * kv[jj][0] + q[tq][jj][1] * kv[jj][1] + q[tq][jj][2] * kv[jj][2] + q[tq][jj][3] * kv[jj][3];
      d += __shfl_xor(d, 1); d += __shfl_xor(d, 2); d += __shfl_xor(d, 4); d += __shfl_xor(d, 8);
      if (li == 0) S[tq * 256 + m] = d * 0.0625f;
    }
  }
  f32x4 vpre[16];
#pragma unroll
  for (int mi = 0; mi < 16; ++mi) vpre[mi] = __builtin_nontemporal_load((const f32x4*)(Vc + (size_t)(wid * 32 + mi) * 1024 + lane * 4));
  __syncthreads();
  if (wid < 4) {
    float s[4]; float mx = -3.0e38f;
#pragma unroll
    for (int i = 0; i < 4; ++i) { s[i] = S[wid * 256 + i * 64 + lane]; mx = fmaxf(mx, s[i]); }
    mx = wave_max(mx); float sum = 0.f;
#pragma unroll
    for (int i = 0; i < 4; ++i) { s[i] = __expf(s[i] - mx); sum += s[i]; }
    sum = wave_sum(sum); const float inv = 1.f / sum;
#pragma unroll
    for (int i = 0; i < 4; ++i) Pm[wid * 256 + i * 64 + lane] = s[i] * inv;
  }
  f32x4 vpost[16];
#pragma unroll
  for (int mi = 0; mi < 16; ++mi) vpost[mi] = __builtin_nontemporal_load((const f32x4*)(Vc + (size_t)(wid * 32 + 16 + mi) * 1024 + lane * 4));
  __syncthreads();
  f32x4 o[4];
#pragma unroll
  for (int tq = 0; tq < 4; ++tq) o[tq] = (f32x4){0.f, 0.f, 0.f, 0.f};
#pragma unroll
  for (int mi = 0; mi < 16; ++mi) {
    const int m = wid * 32 + mi;
#pragma unroll
    for (int tq = 0; tq < 4; ++tq) o[tq] += vpre[mi] * Pm[tq * 256 + m];
  }
#pragma unroll
  for (int mi = 0; mi < 16; ++mi) {
    const int m = wid * 32 + 16 + mi;
#pragma unroll
    for (int tq = 0; tq < 4; ++tq) o[tq] += vpost[mi] * Pm[tq * 256 + m];
  }
#pragma unroll
  for (int tq = 0; tq < 4; ++tq) *(LAS f32x4*)(Op + (wid * 4 + tq) * 256 + lane * 4) = o[tq];
  __syncthreads();
#pragma unroll
  for (int i = 0; i < 2; ++i) {
    const int idx = tid + i * 512, tq = idx >> 8, d = idx & 255; float s = 0.f;
#pragma unroll
    for (int w = 0; w < 8; ++w) s += Op[(w * 4 + tq) * 256 + d];
    p.ob[(size_t)(NP + b * 4 + tq) * 1024 + h * 256 + d] = f2bf(s);
  }
}

__device__ __forceinline__ void phase8(LAS unsigned char* lds, const Params& p) {
  const bool pf = ((blockIdx.x >> 3) & 1) != 0;
  if (pf) for (int it = blockIdx.x; it < 256; it += gridDim.x) attn_prompt_unit(lds, p, it);
  for (int it = blockIdx.x; it < 512; it += gridDim.x) attn_sample_unit((LAS float*)lds, p, it);
  if (!pf) for (int it = blockIdx.x; it < 256; it += gridDim.x) attn_prompt_unit(lds, p, it);
}

template <bool PRE>
__device__ __forceinline__ void p11_tile(LAS unsigned char* lds, const Params& p, int pm, int pn, bool has_next, int pm2, int pn2) {
  __syncthreads();
  f32x4 acc[2][2][4][2];
  gemm_core<PRE>(lds, p.x2b + (size_t)pm * 256 * 1024, 1024, p.WguT + (size_t)pn * 256 * 1024, 1024, 1024, acc);
  int tid = threadIdx.x; asm volatile("" : "+v"(tid));
  const int wid = tid >> 6, lane = tid & 63, wr = wid >> 2, wc = wid & 3, fr = lane & 15, fq = lane >> 4;
  float rs[2][4];
#pragma unroll
  for (int ai = 0; ai < 2; ++ai)
#pragma unroll
    for (int m = 0; m < 4; ++m) rs[ai][m] = p.rstd2[pm * 256 + ai * 128 + wr * 64 + m * 16 + fr];
  asm volatile("s_waitcnt vmcnt(0)" ::: "memory");
  if (has_next) gemm_prestage(lds, p.x2b + (size_t)pm2 * 256 * 1024, 1024, p.WguT + (size_t)pn2 * 256 * 1024, 1024);
#pragma unroll
  for (int ai = 0; ai < 2; ++ai)
#pragma unroll
    for (int m = 0; m < 4; ++m) {
      const int row = pm * 256 + ai * 128 + wr * 64 + m * 16 + fr; const float r_ = rs[ai][m];
      f32x4 o0, o1;
#pragma unroll
      for (int j = 0; j < 4; ++j) { o0[j] = siluf_(acc[ai][0][m][0][j] * r_) * (acc[ai][1][m][0][j] * r_); o1[j] = siluf_(acc[ai][0][m][1][j] * r_) * (acc[ai][1][m][1][j] * r_); }
      u32x4 ov = {pack2(o0[0], o0[1]), pack2(o0[2], o0[3]), pack2(o1[0], o1[1]), pack2(o1[2], o1[3])};
      *(u32x4*)(p.actb + (size_t)row * DFF + pn * 128 + wc * 32 + fq * 8) = ov;
      __builtin_amdgcn_sched_barrier(0);
    }
}
__device__ __forceinline__ void phase11(LAS unsigned char* lds, const Params& p) {
  bool pre = false;
  for (int r = 0; r * (int)gridDim.x < 66 * 22; ++r) {
    const int it = xcd_tile_id(r);
    if (it >= 66 * 22) break;
    int pm, pn; tile_pmn(it, 66, 22, 4, pm, pn);
    const int it2 = xcd_tile_id(r + 1); const bool has_next = it2 < 66 * 22;
    int pm2 = 0, pn2 = 0; if (has_next) tile_pmn(it2, 66, 22, 4, pm2, pn2);
    if (pre) p11_tile<true>(lds, p, pm, pn, has_next, pm2, pn2); else p11_tile<false>(lds, p, pm, pn, has_next, pm2, pn2);
    pre = has_next;
  }
}

template <int PH>
__device__ __forceinline__ void run_phase(LAS unsigned char* lds, const Params& p) {
  if constexpr (PH == 0) phase0(lds, p);
  else if constexpr (PH == 1) phase1(lds, p);
  else if constexpr (PH == 2) phase2(lds, p);
  else if constexpr (PH == 3) phase3(lds, p);
  else if constexpr (PH == 4) phase4(lds, p);
  else if constexpr (PH == 5 || PH == 9 || PH == 12) {
    auto epi = [=](int row, int c0, f32x4 v0, f32x4 v1) -> float {
      st_bf4(p.gob + (size_t)row * 1024 + c0, v0); st_bf4(p.gob + (size_t)row * 1024 + c0 + 128, v1); return sq4(v0) + sq4(v1); };
    auto epi8 = [=](int row, int c0, f32x4 a0, f32x4 a1, f32x4 b0, f32x4 b1) -> float {
      st_bf8(p.gob + (size_t)row * 1024 + c0, a0, a1); st_bf8(p.gob + (size_t)row * 1024 + c0 + 128, b0, b1); return sq4(a0) + sq4(a1) + sq4(b0) + sq4(b1); };
    if constexpr (PH == 5) gemm_n1024<true>(lds, p, p.mix, 1024, p.WoutT, 1024, epi, epi8);
    else if constexpr (PH == 9) gemm_n1024<true>(lds, p, p.ob, 1024, p.WoT, 1024, epi, epi8);
    else gemm_n1024<true>(lds, p, p.actb, DFF, p.WdT, DFF, epi, epi8);
  }
  else if constexpr (PH == 6) resid_phase<1>(p);
  else if constexpr (PH == 7) {
    auto epi = [=](int row, int c0, f32x4 v0, f32x4 v1) -> float {
      const float rs = p.rstd1[row]; st_bf4(p.qb + (size_t)row * 1024 + c0, v0 * rs); st_bf4(p.qb + (size_t)row * 1024 + c0 + 128, v1 * rs); return 0.f; };
    auto epi8 = [=](int row, int c0, f32x4 a0, f32x4 a1, f32x4 b0, f32x4 b1) -> float {
      const float rs = p.rstd1[row]; st_bf8(p.qb + (size_t)row * 1024 + c0, a0 * rs, a1 * rs); st_bf8(p.qb + (size_t)row * 1024 + c0 + 128, b0 * rs, b1 * rs); return 0.f; };
    gemm_n1024<false>(lds, p, p.x1b, 1024, p.WqT, 1024, epi, epi8);
  }
  else if constexpr (PH == 8) phase8(lds, p);
  else if constexpr (PH == 10) resid_phase<2>(p);
  else if constexpr (PH == 11) phase11(lds, p);
  else if constexpr (PH == 13) resid_phase<3>(p);
}

#if MEGA
#ifndef PROBE_MASK
#define PROBE_MASK 0
#endif
#define XB_TMO      128
#define XB_XCNT(j)  (256  + 64 * (j))
#define XB_XSUB(j)  (1280 + 64 * (j))
#define XB_XGEN(j)  (2304 + 64 * (j))
#define XB_TOP      3328
#define XB_TOPGEN   3392
#define XCD_BAR_WORDS 3456
#define XB_SPIN_CAP (1u << 18)
__device__ __forceinline__ unsigned xb_ld(unsigned* p)              { return __hip_atomic_load(p, __ATOMIC_RELAXED, __HIP_MEMORY_SCOPE_AGENT); }
__device__ __forceinline__ unsigned xb_add(unsigned* p, unsigned v) { return __hip_atomic_fetch_add(p, v, __ATOMIC_RELAXED, __HIP_MEMORY_SCOPE_AGENT); }
__device__ __forceinline__ unsigned xb_xcc_id() { return (unsigned)__builtin_amdgcn_s_getreg((3 << 11) | 20) & 0xFu; }
#define XB_SPIN(cond, bar) do { unsigned _sp = 0; while (cond) { __builtin_amdgcn_s_sleep(1); \
    if ((++_sp & 255u) == 0u) { if (xb_ld(&(bar)[XB_TMO])) break; if (_sp > XB_SPIN_CAP) { atomicAdd(&(bar)[XB_TMO], 1u); break; } } } } while (0)
struct XcdBarrier { unsigned* bar; unsigned x; volatile LAS unsigned* st; };
__device__ __forceinline__ XcdBarrier xcd_barrier_post(unsigned* bar, volatile LAS unsigned* st) {
  XcdBarrier b; b.bar = bar; b.x = xb_xcc_id(); b.st = st;
  if (threadIdx.x == 0) (void)xb_add(&bar[XB_XCNT(b.x)], 1u);
  return b;
}
__device__ __forceinline__ void xcd_barrier_complete(unsigned* bar, unsigned x, unsigned& nloc, unsigned& nx) {
  const unsigned G = gridDim.x * gridDim.y * gridDim.z;
  unsigned sum, cnt, mine, sp = 0u;
  for (;;) {
    sum = 0u; cnt = 0u; mine = 0u;
#pragma unroll
    for (unsigned j = 0; j < 16; ++j) { const unsigned c = xb_ld(&bar[XB_XCNT(j)]); sum += c; cnt += (c > 0u) ? 1u : 0u; mine = (j == x) ? c : mine; }
    if (sum == G) break;
    __builtin_amdgcn_s_sleep(1);
    if ((++sp & 255u) == 0u) { if (xb_ld(&bar[XB_TMO])) break; if (sp > XB_SPIN_CAP) { atomicAdd(&bar[XB_TMO], 1u); break; } }
  }
  nloc = mine > 0u ? mine : 1u; nx = cnt > 0u ? cnt : 1u;
}
__device__ __forceinline__ void xcd_barrier(const XcdBarrier& b) {
  asm volatile("s_waitcnt vmcnt(0)" ::: "memory");
  __syncthreads();
  if (threadIdx.x == 0) {
    unsigned* bar = b.bar;
    __builtin_amdgcn_s_waitcnt(0);
    unsigned nloc = b.st[0], nx = b.st[1];
    if (nloc == 0u) { xcd_barrier_complete(bar, b.x, nloc, nx); b.st[0] = nloc; b.st[1] = nx; }
    const unsigned old = xb_add(&bar[XB_XSUB(b.x)], 1u);
    const unsigned gen = old / nloc;
    if (old + 1u == (gen + 1u) * nloc) {
      __builtin_amdgcn_fence(__ATOMIC_RELEASE, "agent");
      asm volatile("s_waitcnt vmcnt(0)" ::: "memory");
      const unsigned og = xb_add(&bar[XB_TOP], 1u);
      const unsigned tg = og / nx;
      if (og + 1u == (tg + 1u) * nx) xb_add(&bar[XB_TOPGEN], 1u);
      else XB_SPIN(xb_ld(&bar[XB_TOPGEN]) == tg, bar);
      __builtin_amdgcn_fence(__ATOMIC_ACQUIRE, "agent");
      xb_add(&bar[XB_XGEN(b.x)], 1u);
      asm volatile("s_waitcnt vmcnt(0)" ::: "memory");
    } else {
      XB_SPIN(xb_ld(&bar[XB_XGEN(b.x)]) == gen, bar);
      __builtin_amdgcn_fence(__ATOMIC_ACQUIRE, "agent");
      asm volatile("s_waitcnt vmcnt(0)" ::: "memory");
    }
  }
  __syncthreads();
}
#define RUN_PH(ph) do { run_phase<ph>(lds, p); if ((PROBE_MASK >> (ph)) & 1) { xcd_barrier(xb); run_phase<ph>(lds, p); } } while (0)
#define BAR_PH() xcd_barrier(xb)
__global__ void __launch_bounds__(NTHR) k_mega(Params p) {
  extern __shared__ __attribute__((aligned(16))) unsigned char shm[];
  LAS unsigned char* lds = (LAS unsigned char*)shm;
  cg::grid_group grid = cg::this_grid();
  volatile LAS unsigned* xst = (volatile LAS unsigned*)(lds + 8 * HTB);
  if (threadIdx.x == 0) { xst[0] = 0u; xst[1] = 0u; xst[2] = 0u; xst[3] = 0u; }
  __syncthreads();
  const XcdBarrier xb = xcd_barrier_post(p.bar, xst);
  RUN_PH(0);
  if (p.bar == nullptr) grid.sync();
  BAR_PH();
  RUN_PH(1); BAR_PH();
  RUN_PH(2); BAR_PH();
  RUN_PH(4); BAR_PH();
  RUN_PH(5); BAR_PH();
  RUN_PH(6); BAR_PH();
  RUN_PH(7); BAR_PH();
  RUN_PH(8); BAR_PH();
  RUN_PH(9); BAR_PH();
  RUN_PH(10); BAR_PH();
  RUN_PH(11); BAR_PH();
  RUN_PH(12); BAR_PH();
  RUN_PH(13);
}
#else
template <int PH>
__global__ void __launch_bounds__(NTHR) k_phase(Params p) {
  extern __shared__ __attribute__((aligned(16))) unsigned char shm[];
  run_phase<PH>((LAS unsigned char*)shm, p);
}
template <int PH>
static void launch_phase(const Params& p, hipStream_t stream) {
  static bool attr = false;
  if (!attr) { (void)hipFuncSetAttribute((const void*)k_phase<PH>, hipFuncAttributeMaxDynamicSharedMemorySize, LDS_BYTES); attr = true; }
  hipLaunchKernelGGL(k_phase<PH>, dim3(256), dim3(NTHR), LDS_BYTES, stream, p);
}
#endif

extern "C" void kernel_launch(void* const* d_in, const int* in_sizes, int n_in, void* d_out, int out_size, void* d_ws, size_t ws_size, hipStream_t stream) {
  Params p{};
  const float** ins = (const float**)&p.x_prompt;
  for (int i = 0; i < 32; ++i) ins[i] = (const float*)d_in[i];
  float* o = (float*)d_out;
  p.y = o; o += (size_t)NTOK * 1024;
  p.memk = o; o += 2097152; p.memv = o; o += 2097152;
  p.convp = o; o += 122880; p.sre_p = o; o += 16384; p.sim_p = o; o += 16384;
  p.convs = o; o += 1966080; p.sre_s = o; o += 262144; p.sim_s = o;
  char* w = (char*)d_ws; size_t off = 0;
  auto take = [&](size_t bytes) { char* r = w + off; off += (bytes + 255) & ~(size_t)255; return r; };
  char* r1 = take((size_t)NTOK * DFF * 2 + (size_t)16 * 1024 * 1024);
  {
    size_t o1 = 0; auto t1 = [&](size_t bytes) { char* r = r1 + o1; o1 += (bytes + 255) & ~(size_t)255; return r; };
    p.xb = (bf16_t*)t1((size_t)NTOK * 1024 * 2);
    p.vbuf = (bf16_t*)t1((size_t)NTOK * 512 * 2);
    p.A2 = (bf16_t*)t1((size_t)32 * 1024 * 384 * 2);
    p.Sst = (float*)t1((size_t)32 * 1024 * 128 * 4);
    p.yact = (bf16_t*)t1((size_t)NTOK * 512 * 2);
    p.actb = (bf16_t*)r1;
  }
  p.memb = (bf16_t*)take((size_t)2048 * 1024 * 2);
  p.WinT = (bf16_t*)take((size_t)1536 * 1024 * 2);
  p.WkvT = (bf16_t*)take((size_t)2048 * 1024 * 2);
  p.WgluT = (bf16_t*)take((size_t)512 * 512 * 2);
  p.WoutT = (bf16_t*)take((size_t)1024 * 1024 * 2);
  p.WqT = (bf16_t*)take((size_t)1024 * 1024 * 2);
  p.WoT = (bf16_t*)take((size_t)1024 * 1024 * 2);
  p.WguT = (bf16_t*)take((size_t)5632 * 1024 * 2);
  p.WdT = (bf16_t*)take((size_t)1024 * DFF * 2);
  p.TY = (bf16_t*)take((size_t)32 * 256 * 384 * 2);
  p.ST = (bf16_t*)take((size_t)32 * 256 * 256 * 2);
  p.mix = (bf16_t*)take((size_t)NTOK * 1024 * 2);
  p.Pscr = p.mix;
  p.gob = (bf16_t*)take((size_t)NTOK * 1024 * 2);
  p.x1b = (bf16_t*)take((size_t)NTOK * 1024 * 2);
  p.qb = (bf16_t*)take((size_t)NTOK * 1024 * 2);
  p.kb = (bf16_t*)take((size_t)8 * 4 * 256 * 256 * 2);
  p.vT = (bf16_t*)take((size_t)8 * 4 * 256 * 256 * 2);
  p.ob = (bf16_t*)take((size_t)NTOK * 1024 * 2);
  p.x2b = (bf16_t*)take((size_t)NTOK * 1024 * 2);
  p.rstd0 = (float*)take((size_t)NTOK * 4); p.rstdm = (float*)take(2048 * 4);
  p.abar = (float*)take(32 * 64 * 2 * 4); p.a16 = (float*)take(32 * 64 * 2 * 4);
  p.Bbre = (float*)take(32 * 64 * 16 * 4); p.Bbim = (float*)take(32 * 64 * 16 * 4);
  p.usamp = (float*)take((size_t)512 * 512 * 4);
  p.ssq = (float*)take((size_t)16 * NTOK * 4);
  p.rstd1 = (float*)take((size_t)NTOK * 4); p.rstd2 = (float*)take((size_t)NTOK * 4);
  p.bar = (unsigned*)take(XCD_BAR_WORDS * 4);
  p.apw = (float*)take((size_t)32 * 2176 * 4); p.Ktab = (float*)take((size_t)32 * 4096 * 4);
  if (off > ws_size) { fprintf(stderr, "workspace too small: need %zu have %zu\n", off, ws_size); return; }
#if MEGA
  static int grid_blocks = 0;
  if (!grid_blocks) {
    (void)hipFuncSetAttribute((const void*)k_mega, hipFuncAttributeMaxDynamicSharedMemorySize, LDS_BYTES);
    int dev = 0, cus = 0, per_cu = 0;
    (void)hipGetDevice(&dev);
    (void)hipDeviceGetAttribute(&cus, hipDeviceAttributeMultiprocessorCount, dev);
    (void)hipOccupancyMaxActiveBlocksPerMultiprocessor(&per_cu, (const void*)k_mega, NTHR, LDS_BYTES);
    if (per_cu < 1) per_cu = 1;
    grid_blocks = cus;
  }
  (void)hipMemsetAsync(p.bar, 0, XCD_BAR_WORDS * 4, stream);
  void* args[] = {&p};
  hipError_t e = hipLaunchCooperativeKernel((const void*)k_mega, dim3(grid_blocks), dim3(NTHR), args, LDS_BYTES, stream);
  if (e != hipSuccess) fprintf(stderr, "cooperative launch failed: %s (grid %d)\n", hipGetErrorString(e), grid_blocks);
#else
  launch_phase<0>(p, stream); launch_phase<1>(p, stream); launch_phase<2>(p, stream); launch_phase<3>(p, stream);
  launch_phase<4>(p, stream); launch_phase<5>(p, stream); launch_phase<6>(p, stream); launch_phase<7>(p, stream);
  launch_phase<8>(p, stream); launch_phase<9>(p, stream); launch_phase<10>(p, stream); launch_phase<11>(p, stream);
  launch_phase<12>(p, stream); launch_phase<13>(p, stream);
#endif
}
```
